# Optimizing an MI355X kernel written in HIP

```python
import jax, jax.numpy as jnp
from jax import lax
import numpy as np

D_MODEL = 1024
BATCH = 4
SEQ = 4096
DEPTH = 2

N_HEADS = 8
HEAD_DIM = 128
ATTN_WIDTH = N_HEADS * HEAD_DIM
IDX_HEADS = 16
IDX_DIM = 64
TOPK_MAX = 256
Q_BLOCK = 128
D_RNN = 1408
RNN_BLOCKS = 16
RNN_BLOCK_DIM = D_RNN // RNN_BLOCKS
CONV_WIDTH = 4
LRU_C = 8.0
ROPE_THETA = 10000.0
NORM_EPS = 1e-6

SPLIT_SIZES = (ATTN_WIDTH, ATTN_WIDTH, ATTN_WIDTH, ATTN_WIDTH,
               IDX_HEADS * IDX_DIM, IDX_DIM, IDX_HEADS,
               D_RNN, D_RNN, D_MODEL, D_MODEL)
N_IN = sum(SPLIT_SIZES)

kernel_name = "hybrid_dsa_rglru_gated_parallel"


def rmsnorm(x, g):
    xf = x.astype(jnp.float32)
    y = xf * lax.rsqrt(jnp.mean(xf * xf, axis=-1, keepdims=True) + NORM_EPS)
    return (y * g.astype(jnp.float32)).astype(x.dtype)


def rope_tables(positions, dim):
    inv = ROPE_THETA ** (-jnp.arange(0, dim, 2, dtype=jnp.float32) / dim)
    ang = positions.astype(jnp.float32)[..., None] * inv
    return jnp.cos(ang), jnp.sin(ang)


def apply_rope(x, cos, sin):
    extra = x.ndim - cos.ndim
    shape = cos.shape[:2] + (1,) * extra + cos.shape[2:]
    c, s = cos.reshape(shape), sin.reshape(shape)
    x1, x2 = jnp.split(x.astype(jnp.float32), 2, axis=-1)
    return jnp.concatenate([x1 * c - x2 * s, x2 * c + x1 * s], axis=-1).astype(x.dtype)


def dsa_attention(q, k, v, iq, ik, iw):
    B, S, H, Dh = q.shape
    topk = min(TOPK_MAX, S // 4)
    n_blk = S // Q_BLOCK
    key_pos = jnp.arange(S)
    scale = HEAD_DIM ** -0.5
    iw = iw.astype(jnp.float32) * (IDX_HEADS ** -0.5) * (IDX_DIM ** -0.5)

    def block(i):
        q0 = i * Q_BLOCK
        qb = lax.dynamic_slice_in_dim(q, q0, Q_BLOCK, axis=1)
        iqb = lax.dynamic_slice_in_dim(iq, q0, Q_BLOCK, axis=1)
        iwb = lax.dynamic_slice_in_dim(iw, q0, Q_BLOCK, axis=1)
        qpos = q0 + jnp.arange(Q_BLOCK)
        causal = key_pos[None, :] <= qpos[:, None]
        dots = jnp.einsum('bqhd,bsd->bqhs', iqb, ik, preferred_element_type=jnp.float32)
        idx_score = jnp.einsum('bqh,bqhs->bqs', iwb, jax.nn.relu(dots))
        idx_score = jnp.where(causal[None], idx_score, -jnp.inf)
        _, sel = lax.top_k(idx_score, topk)
        valid = sel <= qpos[None, :, None]
        k_sel = jax.vmap(lambda kb, ib: kb[ib])(k, sel)
        v_sel = jax.vmap(lambda vb, ib: vb[ib])(v, sel)
        logits = jnp.einsum('bqhd,bqkhd->bhqk', qb, k_sel, preferred_element_type=jnp.float32) * scale
        logits = jnp.where(valid[:, None], logits, -jnp.inf)
        p = jax.nn.softmax(logits, axis=-1)
        return jnp.einsum('bhqk,bqkhd->bqhd', p.astype(v.dtype), v_sel)

    out = lax.map(block, jnp.arange(n_blk))
    return out.transpose(1, 0, 2, 3, 4).reshape(B, S, H, Dh)


def causal_depthwise_conv(x, w, b):
    y = lax.conv_general_dilated(
        x, w[:, None, :].astype(x.dtype), window_strides=(1,),
        padding=[(CONV_WIDTH - 1, 0)], dimension_numbers=('NWC', 'WIO', 'NWC'),
        feature_group_count=x.shape[-1])
    return y + b.astype(x.dtype)


def rg_lru(x, w_r, b_r, w_i, b_i, lam):
    B, S, _ = x.shape
    xb = x.reshape(B, S, RNN_BLOCKS, RNN_BLOCK_DIM)
    r = jax.nn.sigmoid((jnp.einsum('bsnc,ncd->bsnd', xb, w_r).reshape(B, S, D_RNN) + b_r).astype(jnp.float32))
    i = jax.nn.sigmoid((jnp.einsum('bsnc,ncd->bsnd', xb, w_i).reshape(B, S, D_RNN) + b_i).astype(jnp.float32))
    log_a = -LRU_C * r * jax.nn.softplus(-lam.astype(jnp.float32))
    a = jnp.exp(log_a)
    u = jnp.sqrt(-jnp.expm1(2.0 * log_a)) * (i * x.astype(jnp.float32))

    def combine(left, right):
        a_l, b_l = left
        a_r, b_r = right
        return a_l * a_r, a_r * b_l + b_r

    _, h = lax.associative_scan(combine, (a, u), axis=1)
    return h.astype(x.dtype)


def setup_inputs(seed: int = 0) -> dict:
    key = jax.random.key(seed)
    ks = jax.random.split(key, 16)
    f32 = jnp.float32
    x = jax.random.normal(ks[0], (BATCH, SEQ, D_MODEL), f32)
    positions = jnp.broadcast_to(jnp.arange(SEQ, dtype=jnp.int32), (BATCH, SEQ))
    norm_g = 1.0 + 0.02 * jax.random.normal(ks[1], (DEPTH, D_MODEL), f32)
    w_in = jax.random.normal(ks[2], (DEPTH, D_MODEL, N_IN), f32) * D_MODEL ** -0.5
    conv_w = jax.random.normal(ks[3], (DEPTH, CONV_WIDTH, D_RNN), f32) * CONV_WIDTH ** -0.5
    conv_b = 0.01 * jax.random.normal(ks[4], (DEPTH, D_RNN), f32)
    w_rg = jax.random.normal(ks[5], (DEPTH, RNN_BLOCKS, RNN_BLOCK_DIM, RNN_BLOCK_DIM), f32) * RNN_BLOCK_DIM ** -0.5
    b_rg = 0.01 * jax.random.normal(ks[6], (DEPTH, D_RNN), f32)
    w_ig = jax.random.normal(ks[7], (DEPTH, RNN_BLOCKS, RNN_BLOCK_DIM, RNN_BLOCK_DIM), f32) * RNN_BLOCK_DIM ** -0.5
    b_ig = 0.01 * jax.random.normal(ks[8], (DEPTH, D_RNN), f32)
    a0 = jax.random.uniform(ks[9], (DEPTH, D_RNN), f32, 0.9, 0.999)
    p = a0 ** (1.0 / LRU_C)
    lru_lambda = jnp.log(p) - jnp.log1p(-p)
    w_out_attn = jax.random.normal(ks[10], (DEPTH, ATTN_WIDTH, D_MODEL), f32) * ATTN_WIDTH ** -0.5
    w_out_rnn = jax.random.normal(ks[11], (DEPTH, D_RNN, D_MODEL), f32) * D_RNN ** -0.5
    w_o = jax.random.normal(ks[12], (DEPTH, D_MODEL, D_MODEL), f32) * D_MODEL ** -0.5
    final_g = 1.0 + 0.02 * jax.random.normal(ks[13], (D_MODEL,), f32)
    return {"x": x, "positions": positions, "norm_g": norm_g, "w_in": w_in,
            "conv_w": conv_w, "conv_b": conv_b, "w_rg": w_rg, "b_rg": b_rg,
            "w_ig": w_ig, "b_ig": b_ig, "lru_lambda": lru_lambda,
            "w_out_attn": w_out_attn, "w_out_rnn": w_out_rnn, "w_o": w_o,
            "final_g": final_g}


def reference(x, positions, norm_g, w_in, conv_w, conv_b, w_rg, b_rg, w_ig, b_ig,
              lru_lambda, w_out_attn, w_out_rnn, w_o, final_g):
    B, S, _ = x.shape
    offsets = np.cumsum(SPLIT_SIZES)[:-1].tolist()
    cos_a, sin_a = rope_tables(positions, HEAD_DIM)
    cos_i, sin_i = rope_tables(positions, IDX_DIM)
    for l in range(DEPTH):
        h = rmsnorm(x, norm_g[l])
        proj = h @ w_in[l]
        q, k, v, ga, iq, ik, iw, xr, gr, ma, mb = jnp.split(proj, offsets, axis=-1)
        q = apply_rope(q.reshape(B, S, N_HEADS, HEAD_DIM), cos_a, sin_a)
        k = apply_rope(k.reshape(B, S, N_HEADS, HEAD_DIM), cos_a, sin_a)
        v = v.reshape(B, S, N_HEADS, HEAD_DIM)
        iq = apply_rope(iq.reshape(B, S, IDX_HEADS, IDX_DIM), cos_i, sin_i)
        ik = apply_rope(ik, cos_i, sin_i)
        attn = dsa_attention(q, k, v, iq, ik, iw).reshape(B, S, ATTN_WIDTH)
        y_a = (attn * jax.nn.silu(ga)) @ w_out_attn[l]
        xr = causal_depthwise_conv(xr, conv_w[l], conv_b[l])
        hr = rg_lru(xr, w_rg[l], b_rg[l], w_ig[l], b_ig[l], lru_lambda[l])
        y_b = (hr * jax.nn.silu(gr)) @ w_out_rnn[l]
        merged = jax.nn.sigmoid(ma) * y_a + jax.nn.sigmoid(mb) * y_b
        x = x + merged @ w_o[l]
    return rmsnorm(x, final_g)
```

```cpp
#include <hip/hip_runtime.h>
#include <hip/hip_cooperative_groups.h>
#include <cstdio>
#include <cstdint>
namespace cg = cooperative_groups;

#ifndef N_LAUNCH_MODE
#define N_LAUNCH_MODE 0
#endif

#define DEVI __device__ __forceinline__
#define LAS __attribute__((address_space(3)))
typedef unsigned short bf16_t;
typedef short bf16x8 __attribute__((ext_vector_type(8)));
typedef short s16x4 __attribute__((ext_vector_type(4)));
typedef float f32x2 __attribute__((ext_vector_type(2)));
typedef float f32x4 __attribute__((ext_vector_type(4)));
typedef float f32x16 __attribute__((ext_vector_type(16)));
typedef unsigned u32x2 __attribute__((ext_vector_type(2)));
typedef unsigned u32x4 __attribute__((ext_vector_type(4)));
typedef unsigned long long u64;

constexpr int T = 16384, S = 4096, NB = 4, DM = 1024, DR = 1408, NIN = 10064;
constexpr int LDS_BYTES = 140 * 1024;
constexpr int NPH = 14;

__device__ const float c_inv128[64] = {
1.0f,0.865964353f,0.749894202f,0.649381638f,0.562341332f,0.486967534f,0.421696514f,0.365174115f,0.316227764f,0.273841977f,0.237137377f,0.2053525f,0.177827939f,0.153992653f,0.133352146f,0.115478195f,0.100000001f,0.0865964293f,0.0749894232f,0.0649381652f,0.0562341325f,0.0486967526f,0.0421696492f,0.0365174115f,0.0316227749f,0.0273841955f,0.0237137377f,0.0205352511f,0.0177827943f,0.0153992651f,0.013335214f,0.0115478197f,0.00999999978f,0.00865964312f,0.00749894232f,0.00649381615f,0.00562341325f,0.00486967526f,0.00421696482f,0.00365174119f,0.00316227763f,0.00273841969f,0.00237137382f,0.00205352507f,0.00177827943f,0.00153992651f,0.00133352145f,0.00115478202f,0.00100000005f,0.000865964335f,0.000749894185f,0.000649381604f,0.000562341302f,0.000486967532f,0.000421696517f,0.000365174114f,0.000316227757f,0.000273841957f,0.00023713737f,0.00020535251f,0.00017782794f,0.00015399266f,0.00013335215f,0.0001154782f};

constexpr size_t OFF_WA = 0, OFF_WB = (size_t)1024 * 1024, OFF_WO = OFF_WB + (size_t)1024 * 1408, OFF_WG = OFF_WO + (size_t)1024 * 1024, WSM_ELEMS = OFF_WG + (size_t)2 * 16 * 96 * 96;

struct Params {
    const float* x; const int* pos; const float* norm_g; const float* w_in; const float* conv_w; const float* conv_b;
    const float* w_rg; const float* b_rg; const float* w_ig; const float* b_ig; const float* lam;
    const float* w_oa; const float* w_or; const float* w_o; const float* fin_g;
    float* out;
    bf16_t* WinT; bf16_t* Wsm0; bf16_t* Wsm1;
    bf16_t* xb; float* ssq; bf16_t* q; bf16_t* k; bf16_t* v; bf16_t* iq; bf16_t* ik; float* iw; bf16_t* xr; bf16_t* sgr;
    u64* bm; float* agg;
};

DEVI unsigned cvtpk(float lo, float hi) { unsigned r; asm volatile("v_cvt_pk_bf16_f32 %0, %1, %2" : "=v"(r) : "v"(lo), "v"(hi)); return r; }
DEVI float bf_lo(unsigned w) { return __uint_as_float(w << 16); }
DEVI float bf_hi(unsigned w) { return __uint_as_float(w & 0xffff0000u); }
DEVI bf16_t f2bf(float f) { return (bf16_t)(cvtpk(f, 0.f) & 0xffffu); }
DEVI float sigmoidf_(float x) { return 1.0f / (1.0f + __expf(-x)); }
DEVI float siluf_(float x) { return x / (1.0f + __expf(-x)); }
DEVI int otid() { int t = threadIdx.x; asm volatile("" : "+v"(t)); return t; }
DEVI float wave_sum(float s) {
#pragma unroll
    for (int o = 32; o > 0; o >>= 1) s += __shfl_xor(s, o);
    return s;
}
DEVI float row_rstd(const float* ssq, int row) {
    const f32x4* p = (const f32x4*)(ssq + (size_t)row * 16);
    const f32x4 a = p[0], b = p[1], c = p[2], d = p[3];
    const float s = ((a[0] + a[1]) + (a[2] + a[3])) + ((b[0] + b[1]) + (b[2] + b[3])) + ((c[0] + c[1]) + (c[2] + c[3])) + ((d[0] + d[1]) + (d[2] + d[3]));
    return rsqrtf(s * (1.0f / 1024.0f) + 1e-6f);
}

namespace pg8 {
constexpr int BM = 256, BK = 64, HALF = 128, HTB = HALF * BK * 2, STAGE_BYTES = 8 * HTB, NXCD = 8, WGM = 8;
DEVI int lds_byte(int r, int c) { const int st = (r >> 4) * 2 + (c >> 5), rr = r & 15, cc = c & 31, ob = rr * 64 + cc * 2; return st * 1024 + (ob ^ (((ob >> 9) & 1) << 5)); }
DEVI void stage_rc(int b, int& R, int& C) { const int st = b / 1024, sb = b % 1024, swz = sb ^ (((sb >> 9) & 1) << 5); R = (st >> 1) * 16 + swz / 64; C = (st & 1) * 32 + (swz % 64) / 2; }
DEVI int perm32(int rho) { const int n = rho >> 4, i = rho & 15; return 8 * (i >> 2) + 4 * n + (i & 3); }
struct Unit { int pm, pn; };
struct Gemm { const bf16_t* A; const bf16_t* Bt; int M, N, K; };
struct StaticOrder {
    int nM, nN, nwg, G, c;
    DEVI void init(int M, int N, int G_, int c_) { nM = M / BM; nN = N / BM; nwg = nM * nN; G = G_; c = c_; }
    DEVI bool next(int i, Unit& u) const {
        const long L = (long)i * G + c; if (L >= nwg) return false;
        int wgid = (int)L; { const int q = nwg / NXCD, r = nwg % NXCD, xcd = wgid % NXCD, off = wgid / NXCD; wgid = (xcd < r ? xcd * (q + 1) : r * (q + 1) + (xcd - r) * q) + off; }
        const int nig = WGM * nN, gid = wgid / nig, fm = gid * WGM, gsz = (nM - fm) < WGM ? (nM - fm) : WGM;
        u.pm = fm + ((wgid % nig) % gsz); u.pn = (wgid % nig) / gsz; return true;
    }
    DEVI void a_ready(const Unit&) const {}
    DEVI void done(const Unit&) const {}
};

template <class Epi, class Sched>
DEVI void gemm_phase(LAS unsigned char* lds, const Gemm g, const Sched& S, const Epi& E) {
    const int tid = otid(), wid = __builtin_amdgcn_readfirstlane(tid >> 6), lane = tid & 63, wr = wid >> 2, wc = wid & 3, fr = lane & 15, fq = lane >> 4;
    const int K = g.K, nt = K / BK;
    unsigned voffA[2], voffB[2];
#pragma unroll
    for (int i = 0; i < 2; ++i) { int R, C; stage_rc(tid * 16 + i * 8192, R, C); const int Rb = Epi::PERM ? ((R & ~31) + perm32(R & 31)) : R;
        voffA[i] = (unsigned)(R * K + C) * 2u; voffB[i] = (unsigned)(Rb * K + C) * 2u; }
    const size_t kstep = (size_t)(BK * 2);
    const size_t hstep = (size_t)HALF * K * 2;
    const size_t tstep = 2 * hstep;
    const unsigned ldsw = (unsigned)wid * 1024u;
    const int aoff = lds_byte(wr * 64 + fr, fq * 8), boff = lds_byte(wc * 32 + fr, fq * 8);
#define PG8_SA(b, h) (((b) * 2 + (h)) * HTB)
#define PG8_SB(b, h) ((4 + (b) * 2 + (h)) * HTB)
#define PG8_STAGE(bufoff, gbase, voff) do { _Pragma("unroll") for (int _i = 0; _i < 2; ++_i) \
        __builtin_amdgcn_global_load_lds((const unsigned*)((const char*)(gbase) + (voff)[_i]), (LAS unsigned*)(lds + (bufoff) + ldsw + _i * 8192), 16, 0, 0); } while (0)
#define PG8_LDA(dst, b, h) do { _Pragma("unroll") for (int m = 0; m < 4; ++m) _Pragma("unroll") for (int k = 0; k < 2; ++k) dst[m][k] = *(const LAS bf16x8*)(lds + PG8_SA(b, h) + aoff + m * 2048 + k * 1024); } while (0)
#define PG8_LDB(dst, b, h) do { _Pragma("unroll") for (int n = 0; n < 2; ++n) _Pragma("unroll") for (int k = 0; k < 2; ++k) dst[n][k] = *(const LAS bf16x8*)(lds + PG8_SB(b, h) + boff + n * 2048 + k * 1024); } while (0)
#define PG8_MMA(ai, bj, At, Bt) do { __builtin_amdgcn_s_setprio(1); _Pragma("unroll") for (int m = 0; m < 4; ++m) _Pragma("unroll") for (int n = 0; n < 2; ++n) _Pragma("unroll") for (int k = 0; k < 2; ++k) \
        acc[ai][bj][m][n] = __builtin_amdgcn_mfma_f32_16x16x32_bf16(Bt[n][k], At[m][k], acc[ai][bj][m][n], 0, 0, 0); __builtin_amdgcn_s_setprio(0); } while (0)
#define PG8_WAIT_V(n) asm volatile("s_waitcnt vmcnt(" #n ")" ::: "memory")
#define PG8_WAIT_L(n) asm volatile("s_waitcnt lgkmcnt(" #n ")" ::: "memory")
#define PG8_BAR __builtin_amdgcn_s_barrier()
#define PG8_SCHED __builtin_amdgcn_sched_barrier(0)
    Unit cur, nxt; int ui = 0;
    if (!S.next(0, cur)) return;
    f32x4 acc[2][2][4][2];
#pragma unroll
    for (int a = 0; a < 2; ++a)
#pragma unroll
        for (int b = 0; b < 2; ++b)
#pragma unroll
            for (int m = 0; m < 4; ++m)
#pragma unroll
                for (int n = 0; n < 2; ++n) acc[a][b][m][n] = (f32x4){0.f, 0.f, 0.f, 0.f};
    bf16x8 At[4][2], B0[2][2], B1[2][2];
    const char* cA = (const char*)g.A + (size_t)cur.pm * tstep; const char* cB = (const char*)g.Bt + (size_t)cur.pn * tstep;
    S.a_ready(cur);
    PG8_STAGE(PG8_SB(0, 0), cB, voffB); PG8_STAGE(PG8_SA(0, 0), cA, voffA); PG8_STAGE(PG8_SB(0, 1), cB + hstep, voffB); PG8_STAGE(PG8_SA(0, 1), cA + hstep, voffA);
    if (wr == 1) PG8_BAR;
    PG8_WAIT_V(4); PG8_BAR;
    PG8_STAGE(PG8_SB(1, 0), cB + kstep, voffB); PG8_STAGE(PG8_SA(1, 0), cA + kstep, voffA); PG8_STAGE(PG8_SB(1, 1), cB + hstep + kstep, voffB);
    PG8_WAIT_V(6); PG8_BAR;
    for (;;) {
        const bool has_next = S.next(ui + 1, nxt);
        const char* nA = has_next ? (const char*)g.A + (size_t)nxt.pm * tstep : cA; const char* nB = has_next ? (const char*)g.Bt + (size_t)nxt.pn * tstep : cB;
        for (int t = 0; t < nt; t += 2) {
            const bool last = (t == nt - 2);
            const char* a1 = cA + (size_t)(t + 1) * kstep;
            const char* a2 = last ? nA : cA + (size_t)(t + 2) * kstep; const char* b2 = last ? nB : cB + (size_t)(t + 2) * kstep;
            const char* a3 = a2 + kstep; const char* b3 = b2 + kstep;
            if (last && has_next) S.a_ready(nxt);
            PG8_LDB(B0, 0, 0); PG8_SCHED; PG8_LDA(At, 0, 0); PG8_STAGE(PG8_SA(1, 1), a1 + hstep, voffA);
            PG8_WAIT_L(8); PG8_BAR; PG8_WAIT_L(0); PG8_MMA(0, 0, At, B0); PG8_BAR; PG8_SCHED;
            PG8_LDB(B1, 0, 1); PG8_STAGE(PG8_SB(0, 0), b2, voffB);
            PG8_BAR; PG8_WAIT_L(0); PG8_MMA(0, 1, At, B1); PG8_BAR;
            PG8_LDA(At, 0, 1); PG8_STAGE(PG8_SA(0, 0), a2, voffA);
            PG8_BAR; PG8_WAIT_L(0); PG8_MMA(1, 0, At, B0); PG8_BAR; PG8_SCHED;
            PG8_STAGE(PG8_SB(0, 1), b2 + hstep, voffB);
            PG8_WAIT_V(6); PG8_BAR; PG8_MMA(1, 1, At, B1); PG8_BAR;
            PG8_LDB(B0, 1, 0); PG8_SCHED; PG8_LDA(At, 1, 0); PG8_STAGE(PG8_SA(0, 1), a2 + hstep, voffA);
            PG8_WAIT_L(8); PG8_BAR; PG8_WAIT_L(0); PG8_MMA(0, 0, At, B0); PG8_BAR; PG8_SCHED;
            PG8_LDB(B1, 1, 1); PG8_STAGE(PG8_SB(1, 0), b3, voffB);
            PG8_BAR; PG8_WAIT_L(0); PG8_MMA(0, 1, At, B1); PG8_BAR;
            PG8_LDA(At, 1, 1); PG8_STAGE(PG8_SA(1, 0), a3, voffA);
            PG8_BAR; PG8_WAIT_L(0); PG8_MMA(1, 0, At, B0); PG8_BAR; PG8_SCHED;
            PG8_STAGE(PG8_SB(1, 1), b3 + hstep, voffB);
            PG8_WAIT_V(6); PG8_BAR; PG8_MMA(1, 1, At, B1); PG8_BAR;
        }
        E(acc, cur, wr, wc, fr, fq); S.done(cur);
        if (!has_next) break;
#pragma unroll
        for (int a = 0; a < 2; ++a)
#pragma unroll
            for (int b = 0; b < 2; ++b)
#pragma unroll
                for (int m = 0; m < 4; ++m)
#pragma unroll
                    for (int n = 0; n < 2; ++n) acc[a][b][m][n] = (f32x4){0.f, 0.f, 0.f, 0.f};
        cur = nxt; cA = nA; cB = nB; ++ui;
    }
    PG8_WAIT_V(0);
    if (wr == 0) PG8_BAR;
    PG8_BAR;
#undef PG8_SA
#undef PG8_SB
#undef PG8_STAGE
#undef PG8_LDA
#undef PG8_LDB
#undef PG8_MMA
#undef PG8_WAIT_V
#undef PG8_WAIT_L
#undef PG8_BAR
#undef PG8_SCHED
}
}
using pg8::Unit;

DEVI void store8(bf16_t* p, const f32x4& a, const f32x4& b) { u32x4 w; w.x = cvtpk(a[0], a[1]); w.y = cvtpk(a[2], a[3]); w.z = cvtpk(b[0], b[1]); w.w = cvtpk(b[2], b[3]); *(u32x4*)p = w; }
DEVI void load8f(const bf16_t* p, f32x4& a, f32x4& b) { const u32x4 w = *(const u32x4*)p; a = (f32x4){bf_lo(w.x), bf_hi(w.x), bf_lo(w.y), bf_hi(w.y)}; b = (f32x4){bf_lo(w.z), bf_hi(w.z), bf_lo(w.w), bf_hi(w.w)}; }

struct EpiPA1 {
    static constexpr bool PERM = true;
    const float* ssq; const int* pos; bf16_t* q; bf16_t* k; bf16_t* v; bf16_t* iq; bf16_t* ik; bf16_t* xr; bf16_t* sgr; float* iw;
    DEVI void operator()(const f32x4 (&acc)[2][2][4][2], const Unit& u, int wr, int wc, int fr, int fq) const {
        const int pn = u.pn, row0 = u.pm * 256 + wr * 64 + fr, o = wc * 32 + 8 * fq;
        const bool rope = (pn < 8) || (pn >= 12 && pn < 16) || (pn == 27);
        if (rope) {
            bf16_t* dst; int ld, c1, c2, fi, fs; bool act = true, isw = false;
            if (pn < 8) { const int hsel = o >> 6, i0 = o & 63, head = 2 * (pn & 3) + hsel; dst = pn < 4 ? q : k; ld = 1024; c1 = head * 128 + i0; c2 = c1 + 64; fi = i0; fs = 1; }
            else if (pn < 16) { const int hsel = o >> 5, i0 = o & 31, head = 4 * (pn - 12) + hsel; dst = iq; ld = 1024; c1 = head * 64 + i0; c2 = c1 + 32; fi = 2 * i0; fs = 2; }
            else { dst = ik; ld = 64; c1 = o & 31; c2 = c1 + 32; fi = 2 * (o & 31); fs = 2; act = (wc == 0); isw = (wc == 1 && fq < 2); }
            float inv[8];
#pragma unroll
            for (int e = 0; e < 8; ++e) inv[e] = c_inv128[(fi + fs * e) & 63] * 0.15915494309189535f;
#pragma unroll
            for (int ai = 0; ai < 2; ++ai)
#pragma unroll
                for (int m = 0; m < 4; ++m) {
                    const int row = row0 + ai * 128 + m * 16; const float rs = row_rstd(ssq, row);
                    if (act) {
                        const float ps = (float)pos[row];
                        f32x4 o1[2], o2[2];
#pragma unroll
                        for (int n = 0; n < 2; ++n)
#pragma unroll
                            for (int j = 0; j < 4; ++j) {
                                const float x1 = acc[ai][0][m][n][j] * rs, x2 = acc[ai][1][m][n][j] * rs;
                                const float rev = __builtin_amdgcn_fractf(ps * inv[4 * n + j]);
                                const float sn = __builtin_amdgcn_sinf(rev), cs = __builtin_amdgcn_cosf(rev);
                                o1[n][j] = x1 * cs - x2 * sn; o2[n][j] = x2 * cs + x1 * sn;
                            }
                        store8(dst + (size_t)row * ld + c1, o1[0], o1[1]); store8(dst + (size_t)row * ld + c2, o2[0], o2[1]);
                    } else if (isw) {
                        const float sc = rs * 0.03125f;
                        float* wp = iw + (size_t)row * 16 + 8 * fq;
                        *(f32x4*)wp = acc[ai][0][m][0] * sc; *(f32x4*)(wp + 4) = acc[ai][0][m][1] * sc;
                    }
                }
        } else {
#pragma unroll
            for (int ai = 0; ai < 2; ++ai)
#pragma unroll
                for (int m = 0; m < 4; ++m) {
                    const int row = row0 + ai * 128 + m * 16; const float rs = row_rstd(ssq, row);
#pragma unroll
                    for (int bj = 0; bj < 2; ++bj) {
                        f32x4 a0 = acc[ai][bj][m][0] * rs, a1 = acc[ai][bj][m][1] * rs;
                        if (pn < 12) { store8(v + (size_t)row * 1024 + (pn - 8) * 256 + bj * 128 + o, a0, a1); }
                        else { const int gc = (pn - 16) * 256 + bj * 128 + o;
                            if (gc < DR) store8(xr + (size_t)row * DR + gc, a0, a1);
                            else {
#pragma unroll
                                for (int j = 0; j < 4; ++j) { a0[j] = siluf_(a0[j]); a1[j] = siluf_(a1[j]); }
                                store8(sgr + (size_t)row * DR + gc - DR, a0, a1); } }
                    }
                }
        }
    }
};
struct EpiPA2 {
    static constexpr bool PERM = true;
    const float* ssq; bf16_t* ag; bf16_t* sma; bf16_t* smb;
    DEVI void operator()(const f32x4 (&acc)[2][2][4][2], const Unit& u, int wr, int wc, int fr, int fq) const {
        const int pn = u.pn, row0 = u.pm * 256 + wr * 64 + fr, o = wc * 32 + 8 * fq;
#pragma unroll
        for (int ai = 0; ai < 2; ++ai)
#pragma unroll
            for (int m = 0; m < 4; ++m) {
                const int row = row0 + ai * 128 + m * 16; const float rs = row_rstd(ssq, row);
#pragma unroll
                for (int bj = 0; bj < 2; ++bj) {
                    f32x4 a0 = acc[ai][bj][m][0] * rs, a1 = acc[ai][bj][m][1] * rs;
                    const size_t off = (size_t)row * 1024 + (pn & 3) * 256 + bj * 128 + o;
                    if (pn < 4) { f32x4 g0, g1; load8f(ag + off, g0, g1);
#pragma unroll
                        for (int j = 0; j < 4; ++j) { a0[j] = siluf_(a0[j]) * g0[j]; a1[j] = siluf_(a1[j]) * g1[j]; }
                        store8(ag + off, a0, a1); }
                    else {
#pragma unroll
                        for (int j = 0; j < 4; ++j) { a0[j] = sigmoidf_(a0[j]); a1[j] = sigmoidf_(a1[j]); }
                        store8((pn < 8 ? sma : smb) + off, a0, a1); }
                }
            }
    }
};
template <int MODE> struct EpiPD {
    static constexpr bool PERM = true;
    const bf16_t* gate; const bf16_t* yin; bf16_t* outp;
    DEVI void operator()(const f32x4 (&acc)[2][2][4][2], const Unit& u, int wr, int wc, int fr, int fq) const {
        const int row0 = u.pm * 256 + wr * 64 + fr, o = wc * 32 + 8 * fq;
#pragma unroll
        for (int ai = 0; ai < 2; ++ai)
#pragma unroll
            for (int m = 0; m < 4; ++m) {
                const int row = row0 + ai * 128 + m * 16;
#pragma unroll
                for (int bj = 0; bj < 2; ++bj) {
                    const size_t off = (size_t)row * 1024 + u.pn * 256 + bj * 128 + o;
                    f32x4 g0, g1; load8f(gate + off, g0, g1);
                    f32x4 a0 = acc[ai][bj][m][0] * g0, a1 = acc[ai][bj][m][1] * g1;
                    if (MODE == 1) { f32x4 y0, y1; load8f(yin + off, y0, y1); a0 += y0; a1 += y1; }
                    store8(outp + off, a0, a1);
                }
            }
    }
};
struct EpiPE {
    static constexpr bool PERM = false;
    const float* xin; float* xout; bf16_t* xb; float* ssq;
    DEVI void operator()(const f32x4 (&acc)[2][2][4][2], const Unit& u, int wr, int wc, int fr, int fq) const {
        const int row0 = u.pm * 256 + wr * 64 + fr, col0 = u.pn * 256 + wc * 32 + 4 * fq;
#pragma unroll
        for (int ai = 0; ai < 2; ++ai)
#pragma unroll
            for (int m = 0; m < 4; ++m) {
                const int row = row0 + ai * 128 + m * 16; float s = 0.f;
#pragma unroll
                for (int bj = 0; bj < 2; ++bj)
#pragma unroll
                    for (int n = 0; n < 2; ++n) {
                        const size_t off = (size_t)row * 1024 + col0 + bj * 128 + n * 16;
                        const f32x4 xv = *(const f32x4*)(xin + off) + acc[ai][bj][m][n];
                        *(f32x4*)(xout + off) = xv;
                        u32x2 w; w.x = cvtpk(xv[0], xv[1]); w.y = cvtpk(xv[2], xv[3]); *(u32x2*)(xb + off) = w;
                        s += (xv[0] * xv[0] + xv[1] * xv[1]) + (xv[2] * xv[2] + xv[3] * xv[3]);
                    }
                s += __shfl_xor(s, 16); s += __shfl_xor(s, 32);
                if (fq == 0) ssq[(size_t)row * 16 + u.pn * 4 + wc] = s;
            }
    }
};

namespace at {
constexpr int D = 128, RS = 1024;
constexpr float SCALE = 0.08838834764831845f;
constexpr float THR = 8.f;
constexpr int NW = 8, QBLK = 32, KVBLK = 64, QB = NW * QBLK;
constexpr int SHM_V = KVBLK * D * 2, SHM_K = KVBLK * D * 2;
#define KSWZ(row, colB) ((row) * 256 + ((colB) ^ (((row) & 7) << 4)))
#define SBAR() __builtin_amdgcn_sched_barrier(0)
DEVI int v_st(int k, int c) { const int kk = (k & ~0xC) | ((k & 4) << 1) | ((k & 8) >> 1); return ((kk >> 3) * 4 + (c >> 5)) * 512 + ((kk & 7) * 32 + (c & 31)) * 2; }
DEVI int v_rd_base(int lane) { return ((lane & 3) << 3) | (((lane >> 2) & 3) << 6) | (((lane >> 4) & 1) << 5) | (((lane >> 5) & 1) << 8); }
constexpr int v_rd_off(int d0, int ks, int half) { return d0 * 512 + ks * 4096 + half * 2048; }
DEVI int crow(int r, int hi) { return (r & 3) + 8 * (r >> 2) + 4 * hi; }
DEVI bf16x8 load8(const bf16_t* p) { return *reinterpret_cast<const bf16x8*>(p); }
DEVI void mask_bits(f32x16& p0, f32x16& p1, u64 mw, int hi) {
    const float NEG = -__builtin_inff();
    const unsigned lo = (unsigned)mw >> (4 * hi), hh = (unsigned)(mw >> 32) >> (4 * hi);
#pragma unroll
    for (int r = 0; r < 16; ++r) {
        const int c = (r & 3) + 8 * (r >> 2);
        if (!((lo >> c) & 1u)) p0[r] = NEG;
        if (!((hh >> c) & 1u)) p1[r] = NEG;
    }
}
DEVI void partialSM(f32x16& p0, f32x16& p1, float& m_reg, float& mn, float& alpha) {
    float pmax = p0[0];
#pragma unroll
    for (int r = 1; r < 16; ++r) pmax = fmaxf(pmax, p0[r]);
#pragma unroll
    for (int r = 0; r < 16; ++r) pmax = fmaxf(pmax, p1[r]);
    { auto rr = __builtin_amdgcn_permlane32_swap(__float_as_uint(pmax), __float_as_uint(pmax), false, false);
      pmax = fmaxf(__uint_as_float(rr[0]), __uint_as_float(rr[1])); }
    constexpr float C2 = 1.4426950408889634f * SCALE;
    if (__builtin_expect(__all((pmax - m_reg) * SCALE <= THR), 1)) { mn = m_reg; alpha = 1.f; }
    else { mn = fmaxf(m_reg, pmax); alpha = __builtin_amdgcn_exp2f((m_reg - mn) * C2); m_reg = mn; }
    const float mnL = -mn * C2;
#pragma unroll
    for (int r = 0; r < 16; ++r) p0[r] = fmaf(p0[r], C2, mnL);
#pragma unroll
    for (int r = 0; r < 16; ++r) p1[r] = fmaf(p1[r], C2, mnL);
#pragma unroll
    for (int r = 0; r < 16; ++r) p0[r] = __builtin_amdgcn_exp2f(p0[r]);
}
DEVI void finishSM(f32x16& p0, f32x16& p1, float alpha, float& l_reg, bf16x8& pa0, bf16x8& pa1, bf16x8& pa2, bf16x8& pa3) {
#pragma unroll
    for (int r = 0; r < 16; ++r) p1[r] = __builtin_amdgcn_exp2f(p1[r]);
    float ps = 0;
#pragma unroll
    for (int r = 0; r < 16; ++r) ps += p0[r];
#pragma unroll
    for (int r = 0; r < 16; ++r) ps += p1[r];
    { auto rr = __builtin_amdgcn_permlane32_swap(__float_as_uint(ps), __float_as_uint(ps), false, false);
      ps = __uint_as_float(rr[0]) + __uint_as_float(rr[1]); }
    l_reg = l_reg * alpha + ps;
#define PK4(P, B_, OUT) do { unsigned a0 = cvtpk(P[B_+0], P[B_+1]), a1 = cvtpk(P[B_+2], P[B_+3]);                          \
        unsigned b0 = cvtpk(P[B_+4], P[B_+5]), b1 = cvtpk(P[B_+6], P[B_+7]);                                             \
        auto r0 = __builtin_amdgcn_permlane32_swap(a0, b0, false, false); auto r1 = __builtin_amdgcn_permlane32_swap(a1, b1, false, false); \
        u32x4 w = {r0[0], r1[0], r0[1], r1[1]}; OUT = *reinterpret_cast<bf16x8*>(&w); } while (0)
    PK4(p0, 0, pa0); PK4(p0, 8, pa1); PK4(p1, 0, pa2); PK4(p1, 8, pa3);
#undef PK4
}
template <int KB>
DEVI void qkt(f32x16& p0, f32x16& p1, const char* K_lds, int r32, int hi, const LAS unsigned char* qb) {
    p0 = f32x16{}; p1 = f32x16{};
    const char* kb[4];
#pragma unroll
    for (int dd = 0; dd < 4; ++dd) kb[dd] = K_lds + KB * SHM_K + KSWZ(r32, (dd * 16 + hi * 8) * 2);
#pragma unroll
    for (int d0 = 0; d0 < 8; ++d0) { const char* a = kb[d0 & 3] + (d0 >> 2) * 128;
        bf16x8 b0 = *reinterpret_cast<const bf16x8*>(a);
        bf16x8 b1 = *reinterpret_cast<const bf16x8*>(a + 32 * 256);
        const bf16x8 qf = *(const LAS bf16x8*)(qb + d0 * 1024);
        p0 = __builtin_amdgcn_mfma_f32_32x32x16_bf16(b0, qf, p0, 0, 0, 0);
        p1 = __builtin_amdgcn_mfma_f32_32x32x16_bf16(b1, qf, p1, 0, 0, 0); }
}
template <int VB>
DEVI void pv_tile(f32x16* o, int vb0, bf16x8 pa0, bf16x8 pa1, bf16x8 pa2, bf16x8 pa3) {
#define TRRD(dst, off) asm volatile("ds_read_b64_tr_b16 %0, %1 offset:%2" : "=&v"(dst) : "v"(vb0), "i"(off) : "memory")
#define PV_D0(d0) do { s16x4 l0, l1, l2, l3, h0, h1, h2, h3; constexpr int b_ = VB * SHM_V + v_rd_off(d0, 0, 0); \
        TRRD(l0, b_); TRRD(h0, b_ + 2048); TRRD(l1, b_ + 4096); TRRD(h1, b_ + 6144); TRRD(l2, b_ + 8192); TRRD(h2, b_ + 10240); TRRD(l3, b_ + 12288); TRRD(h3, b_ + 14336); \
        asm volatile("s_waitcnt lgkmcnt(0)" ::: "memory"); SBAR();   \
        o[d0] = __builtin_amdgcn_mfma_f32_32x32x16_bf16(pa0, (bf16x8){l0[0], l0[1], l0[2], l0[3], h0[0], h0[1], h0[2], h0[3]}, o[d0], 0, 0, 0);   \
        o[d0] = __builtin_amdgcn_mfma_f32_32x32x16_bf16(pa1, (bf16x8){l1[0], l1[1], l1[2], l1[3], h1[0], h1[1], h1[2], h1[3]}, o[d0], 0, 0, 0);   \
        o[d0] = __builtin_amdgcn_mfma_f32_32x32x16_bf16(pa2, (bf16x8){l2[0], l2[1], l2[2], l2[3], h2[0], h2[1], h2[2], h2[3]}, o[d0], 0, 0, 0);   \
        o[d0] = __builtin_amdgcn_mfma_f32_32x32x16_bf16(pa3, (bf16x8){l3[0], l3[1], l3[2], l3[3], h3[0], h3[1], h3[2], h3[3]}, o[d0], 0, 0, 0); } while (0)
    PV_D0(0); PV_D0(1); PV_D0(2); PV_D0(3);
#undef PV_D0
#undef TRRD
}
struct BlockRef { const bf16_t* Q; const bf16_t* K; const bf16_t* V; bf16_t* O; const u64* M; int P0; };
struct Stg { bf16x8 st_v0, st_v1, st_k0, st_k1; };
constexpr int MOFF = 2 * SHM_V + 2 * SHM_K + NW * 64 * 4, QOFF = MOFF + 4096;
#define ROW(p, k0, rr) ((p) + (size_t)((k0) + (rr)) * RS + sc)
#define VMW() asm volatile("s_waitcnt vmcnt(0)" ::: "memory")
#define VMWN(n) asm volatile("s_waitcnt vmcnt(%0)" :: "i"(n) : "memory")
#define SLOAD_H(Kp, Vp, k0) do { S.st_v0 = load8(ROW(Vp, k0, sr)); S.st_v1 = load8(ROW(Vp, k0, 32 + sr));              \
                         S.st_k0 = load8(ROW(Kp, k0, sr)); S.st_k1 = load8(ROW(Kp, k0, 32 + sr)); } while (0)
#define SWRITE_HK(bf) do { *(bf16x8*)(K_lds + (bf) * SHM_K + kws) = S.st_k0; *(bf16x8*)(K_lds + (bf) * SHM_K + kws + 32 * 256) = S.st_k1; } while (0)
#define SWRITE_HV(bf) do { *(bf16x8*)(V_lds + (bf) * SHM_V + vst0) = S.st_v0; *(bf16x8*)(V_lds + (bf) * SHM_V + vst1) = S.st_v1; } while (0)
#define SWRITE_H(bf) do { SWRITE_HV(bf); SWRITE_HK(bf); } while (0)
DEVI void attn_block(const BlockRef& cur, char* lds) {
    const int tid = otid(), wid = __builtin_amdgcn_readfirstlane(tid >> 6), lane = tid & 63, r32 = lane & 31, hi = lane >> 5;
    const int NT = (cur.P0 + QB - 1) / KVBLK + 1;
    char* V_lds = lds; char* K_lds = lds + 2 * SHM_V;
    float* ws = (float*)(lds + 2 * SHM_V + 2 * SHM_K) + wid * 64; float* li_l = ws, * al_l = ws + 32;
    float m_reg = -1e30f, l_reg = 0; f32x16 o[4] = {};
    const int sr = tid >> 4, sc = (tid & 15) * 8, vst0 = v_st(sr, sc), vst1 = v_st(32 + sr, sc), kws = KSWZ(sr, sc * 2);
    const int vb0 = (int)(uintptr_t)V_lds + v_rd_base(lane);
    const bf16_t* Kh = cur.K; const bf16_t* Vh = cur.V;
    const char* Mu = (const char*)(cur.M + cur.P0 + wid * QBLK);
    const unsigned lane4 = (unsigned)lane * 4u;
    LAS unsigned char* mlds = (LAS unsigned char*)(lds + MOFF) + wid * 256;
    LAS unsigned char* qb = (LAS unsigned char*)(lds + QOFF) + wid * 8192 + lane * 16;
    Stg S;
#define RESC(a) do { if (__any((a) < 1.f)) { if (hi == 0) al_l[r32] = (a); asm volatile("s_waitcnt lgkmcnt(0)" ::: "memory");              \
                     for (int d_ = 0; d_ < 4; ++d_) for (int r = 0; r < 16; ++r) o[d_][r] *= al_l[crow(r, hi)]; } } while (0)
#define KBASE(t) ((t) * KVBLK)
#define MLOAD(t) do { __builtin_amdgcn_global_load_lds((const unsigned*)(Mu + (size_t)(t) * 32768 + lane4), (LAS unsigned*)(mlds + ((t) & 1) * 2048), 4, 0, 0); } while (0)
#define MASKT(P0_, P1_, t) do { const u64 mw_ = *(const LAS u64*)(mlds + ((t) & 1) * 2048 + r32 * 8); mask_bits(P0_, P1_, mw_, hi); } while (0)
    f32x16 pA0, pA1, pB0, pB1; float mnA, mnB, alA, alB; bf16x8 pa0, pa1, pa2, pa3;
    {
#pragma unroll
        for (int d0 = 0; d0 < 8; ++d0) { const bf16x8 qf = load8(cur.Q + (size_t)(wid * QBLK + r32) * RS + d0 * 16 + hi * 8); *(LAS bf16x8*)(qb + d0 * 1024) = qf; }
        SLOAD_H(Kh, Vh, 0); VMW(); SWRITE_H(0);
    }
    MLOAD(0);
    SLOAD_H(Kh, Vh, KBASE(1));
    __syncthreads();
    SBAR(); qkt<0>(pA0, pA1, K_lds, r32, hi, qb);
    VMWN(4);
    MASKT(pA0, pA1, 0); partialSM(pA0, pA1, m_reg, mnA, alA);
    VMW(); SWRITE_H(1);
    __syncthreads();
#define HALF_STEP(PX0, PX1, mnX, alX, PY0, PY1, alY, t, KB, VB, SB) do {                                                      \
        MLOAD(t);                                                                                                             \
        SBAR(); qkt<KB>(PX0, PX1, K_lds, r32, hi, qb);                                                                       \
        finishSM(PY0, PY1, alY, l_reg, pa0, pa1, pa2, pa3); SBAR();                                                           \
        if ((t) + 1 < NT) { SLOAD_H(Kh, Vh, KBASE((t) + 1)); SBAR(); }                                                        \
        pv_tile<VB>(o, vb0, pa0, pa1, pa2, pa3);                                                                              \
        if ((t) + 1 < NT) VMWN(4); else VMW();                                                                                \
        MASKT(PX0, PX1, t); partialSM(PX0, PX1, m_reg, mnX, alX);                                                             \
        __syncthreads();                                                                                                      \
        if ((t) + 1 < NT) { VMW(); SWRITE_H(SB); }                                                                            \
        RESC(alX); __syncthreads(); } while (0)
    for (int t = 1; t + 1 < NT; t += 2) {
        HALF_STEP(pB0, pB1, mnB, alB, pA0, pA1, alA, t, 1, 0, 0);
        HALF_STEP(pA0, pA1, mnA, alA, pB0, pB1, alB, t + 1, 0, 1, 1);
    }
    const bool even = (NT & 1) == 0;
    if (even) { MLOAD(NT - 1); SBAR(); qkt<1>(pB0, pB1, K_lds, r32, hi, qb); SBAR(); }
    finishSM(pA0, pA1, alA, l_reg, pa0, pa1, pa2, pa3); SBAR();
    pv_tile<0>(o, vb0, pa0, pa1, pa2, pa3);
    if (even) { VMW(); MASKT(pB0, pB1, NT - 1); partialSM(pB0, pB1, m_reg, mnB, alB); __syncthreads(); RESC(alB);
        finishSM(pB0, pB1, alB, l_reg, pa0, pa1, pa2, pa3); SBAR(); pv_tile<1>(o, vb0, pa0, pa1, pa2, pa3); }
    SBAR();
    if (hi == 0) li_l[r32] = l_reg; asm volatile("s_waitcnt lgkmcnt(0)" ::: "memory");
    float rli[16];
#pragma unroll
    for (int r = 0; r < 16; ++r) rli[r] = __builtin_amdgcn_rcpf(li_l[crow(r, hi)]);
    bf16_t* Ow = cur.O + (size_t)(wid * QBLK) * RS;
#pragma unroll
    for (int r = 0; r < 16; ++r) { const int orow = crow(r, hi);
#pragma unroll
        for (int d0 = 0; d0 < 4; ++d0) { const float v = o[d0][r] * rli[r];
            const float vn = __shfl_xor(v, 1);
            if ((r32 & 1) == 0) *(unsigned*)(Ow + (size_t)orow * RS + d0 * 32 + r32) = cvtpk(v, vn); } }
    __syncthreads();
#undef RESC
#undef KBASE
#undef MLOAD
#undef MASKT
#undef HALF_STEP
}
#undef ROW
#undef VMW
#undef VMWN
#undef SLOAD_H
#undef SWRITE_HK
#undef SWRITE_HV
#undef SWRITE_H
}

DEVI at::BlockRef attn_ref(const Params& p, int bh, int qb) {
    const int b = bh >> 3, h = bh & 7; at::BlockRef r;
    const size_t base = (size_t)b * S * 1024 + h * 128;
    r.Q = p.q + base + (size_t)qb * 256 * 1024; r.O = p.q + base + (size_t)qb * 256 * 1024;
    r.K = p.k + base; r.V = p.v + base; r.M = p.bm + (size_t)b * 64 * S; r.P0 = qb * 256;
    return r;
}
DEVI void phase_attention(const Params& p, unsigned char* smem) {
    const int total = 256, G = gridDim.x;
    for (int c = blockIdx.x; c < total; c += G) {
        const int L = (G == 256) ? ((c & 7) * 32 + (c >> 3)) : c;
        const int bh = L >> 3, x = L & 7;
        at::attn_block(attn_ref(p, bh, 15 - x), (char*)smem);
        at::attn_block(attn_ref(p, bh, x), (char*)smem);
    }
}

DEVI void idx_unit(const Params& p, int u, unsigned char* smem) {
    const int tid = otid(), wid = __builtin_amdgcn_readfirstlane(tid >> 6), lane = tid & 63;
    const int slot = u & 255, ii = u >> 8, b = ii >> 1, g = (ii & 1) ? 511 - slot : slot, t0 = g * 8;
    unsigned* keys = (unsigned*)smem;
    u64* wl = (u64*)(smem + 131072);
    const size_t tokb = (size_t)b * S;
    const int nk64 = (t0 + 8 + 63) >> 6;
    if (t0 + 8 > 256) {
        const int rt = wid & 3, kp = wid >> 2, r32 = lane & 31, hi = lane >> 5;
        const int qsel = (r32 >> 2) & 1, head = (r32 & 3) | ((r32 >> 3) << 2);
        const bf16_t* ap = p.iq + (tokb + t0 + 2 * rt + qsel) * 1024 + head * 64 + hi * 8;
        bf16x8 af[4];
#pragma unroll
        for (int s = 0; s < 4; ++s) af[s] = *(const bf16x8*)(ap + s * 16);
        float wv[16];
        { const f32x4* wp = (const f32x4*)(p.iw + (tokb + t0 + 2 * rt + hi) * 16);
#pragma unroll
          for (int i = 0; i < 4; ++i) { const f32x4 w4 = wp[i]; wv[4 * i] = w4[0]; wv[4 * i + 1] = w4[1]; wv[4 * i + 2] = w4[2]; wv[4 * i + 3] = w4[3]; } }
        const int myq = 2 * rt + hi, tq = t0 + myq, ntile = nk64 * 2;
        const bf16_t* kbase = p.ik + tokb * 64 + (size_t)r32 * 64 + hi * 8;
        bf16x8 bfr[4], bnx[4];
#pragma unroll
        for (int s = 0; s < 4; ++s) bfr[s] = *(const bf16x8*)(kbase + (size_t)kp * 32 * 64 + s * 16);
        for (int kt = kp; kt < ntile; kt += 2) {
            const int ktn = (kt + 2 < ntile) ? kt + 2 : kt;
#pragma unroll
            for (int s = 0; s < 4; ++s) bnx[s] = *(const bf16x8*)(kbase + (size_t)ktn * 32 * 64 + s * 16);
            f32x16 acc = {};
#pragma unroll
            for (int s = 0; s < 4; ++s) acc = __builtin_amdgcn_mfma_f32_32x32x16_bf16(af[s], bfr[s], acc, 0, 0, 0);
            float sc = 0.f;
#pragma unroll
            for (int r = 0; r < 16; ++r) sc = fmaf(wv[r], fmaxf(acc[r], 0.f), sc);
            const unsigned bits = __float_as_uint(sc);
            unsigned kk = bits ^ ((unsigned)((int)bits >> 31) | 0x80000000u);
            const int key = kt * 32 + r32;
            if (key > tq) kk = 0u;
            keys[myq * 4096 + key] = kk;
#pragma unroll
            for (int s = 0; s < 4; ++s) bfr[s] = bnx[s];
        }
    }
    __syncthreads();
    {
        const int tq = t0 + wid, n = tq + 1;
        u64 myword = 0;
        if (n <= 256) {
            const int lo = lane * 64;
            myword = (tq >= lo + 63) ? ~0ull : (tq < lo ? 0ull : ((1ull << (tq - lo + 1)) - 1ull));
        } else {
            const int ni = (n + 63) >> 6;
            unsigned kv[64];
#pragma unroll
            for (int i = 0; i < 64; ++i) { const unsigned vv = keys[wid * 4096 + i * 64 + lane]; kv[i] = (i < ni) ? vv : 0u; }
            unsigned prefix = 0; bool exact = false;
#pragma unroll 1
            for (int bit = 31; bit >= 0; --bit) {
                const unsigned cand = prefix | (1u << bit);
                int c = 0;
#pragma unroll
                for (int g8 = 0; g8 < 8; ++g8) {
                    if (g8 * 8 < ni) {
#pragma unroll
                        for (int e = 0; e < 8; ++e) c += __popcll(__ballot(kv[g8 * 8 + e] >= cand));
                    }
                }
                if (c >= 256) { prefix = cand; if (c == 256) { exact = true; break; } }
            }
            unsigned Tt; int need;
            if (exact) { Tt = prefix - 1u; need = 0; }
            else { Tt = prefix; int cgt = 0;
#pragma unroll
                for (int i = 0; i < 64; ++i) cgt += __popcll(__ballot(kv[i] > Tt));
                need = 256 - cgt; }
#pragma unroll
            for (int i = 0; i < 64; ++i) {
                u64 m = __ballot(kv[i] > Tt);
                if (need > 0) {
                    u64 me = __ballot(kv[i] == Tt);
                    const int pc = __popcll(me), take = pc < need ? pc : need;
                    while (__popcll(me) > take) me &= ~(1ull << (63 - __clzll(me)));
                    need -= take; m |= me;
                }
                if (lane == i) myword = m;
            }
        }
        wl[wid * 64 + lane] = myword;
    }
    __syncthreads();
    { const int jj = tid >> 3, qq = tid & 7; p.bm[((size_t)b * 64 + jj) * S + t0 + qq] = wl[qq * 64 + jj]; }
    __syncthreads();
}

DEVI void rnn_unit(const Params& p, int l, int u, bool fin, unsigned char* smem) {
    const int tid = otid(), wid = __builtin_amdgcn_readfirstlane(tid >> 6), lane = tid & 63;
    const int n = u & 15, j = (u >> 4) & 31, b = u >> 9;
    const int t0 = j * 128; const size_t tok0 = (size_t)b * S + t0;
    float* xin = (float*)smem;
    float* xcu = (float*)(smem + 46592);
    bf16_t* xa = (bf16_t*)(smem + 46592 + 45056);
    for (int c = tid; c < 131 * 11; c += 512) {
        const int r = c / 11, cc = c - r * 11, t = t0 - 3 + r;
        f32x4 a0 = {0.f, 0.f, 0.f, 0.f}, a1 = a0;
        if (t >= 0) load8f(p.xr + ((size_t)b * S + t) * DR + n * 88 + cc * 8, a0, a1);
        float* d = xin + r * 88 + cc * 8;
        *(f32x4*)d = a0; *(f32x4*)(d + 4) = a1;
    }
    __syncthreads();
    {
        const float* cw = p.conv_w + (size_t)l * 4 * DR + n * 88; const float* cb = p.conv_b + (size_t)l * DR + n * 88;
        for (int e = tid; e < 128 * 88; e += 512) {
            const int t = e / 88, c = e - t * 88;
            const float vv = cb[c] + cw[c] * xin[t * 88 + c] + cw[DR + c] * xin[(t + 1) * 88 + c] + cw[2 * DR + c] * xin[(t + 2) * 88 + c] + cw[3 * DR + c] * xin[(t + 3) * 88 + c];
            xcu[e] = vv; xa[t * 96 + c] = f2bf(vv);
        }
        for (int e = tid; e < 128 * 8; e += 512) xa[(e >> 3) * 96 + 88 + (e & 7)] = 0;
    }
    __syncthreads();
    {
        const bf16_t* Wg = (l ? p.Wsm1 : p.Wsm0) + OFF_WG;
        const int fr = lane & 15, fq = lane >> 4;
        bf16x8 a[3];
#pragma unroll
        for (int s = 0; s < 3; ++s) a[s] = *(const bf16x8*)(xa + (wid * 16 + fr) * 96 + s * 32 + fq * 8);
        float* aout = xin;
#pragma unroll 1
        for (int nt = 0; nt < 6; ++nt) {
            f32x4 accr = {0.f, 0.f, 0.f, 0.f}, acci = accr;
            const bf16_t* wr_ = Wg + ((size_t)n * 96 + nt * 16 + fr) * 96 + fq * 8;
            const bf16_t* wi_ = wr_ + (size_t)16 * 96 * 96;
#pragma unroll
            for (int s = 0; s < 3; ++s) {
                const bf16x8 br = *(const bf16x8*)(wr_ + s * 32), bi = *(const bf16x8*)(wi_ + s * 32);
                accr = __builtin_amdgcn_mfma_f32_16x16x32_bf16(a[s], br, accr, 0, 0, 0);
                acci = __builtin_amdgcn_mfma_f32_16x16x32_bf16(a[s], bi, acci, 0, 0, 0);
            }
            const int c = nt * 16 + fr;
            if (c < 88) {
                const int gc = l * DR + n * 88 + c;
                const float brg = p.b_rg[gc], big = p.b_ig[gc], sp = log1pf(__expf(-p.lam[gc]));
#pragma unroll
                for (int r = 0; r < 4; ++r) {
                    const int t = wid * 16 + fq * 4 + r;
                    const float rg = sigmoidf_(accr[r] + brg), ig = sigmoidf_(acci[r] + big);
                    const float la = -8.0f * rg * sp, av = __expf(la), mult = sqrtf(-expm1f(2.0f * la));
                    const float xc = xcu[t * 88 + c];
                    aout[t * 88 + c] = av; xcu[t * 88 + c] = mult * ig * xc;
                }
            }
        }
    }
    __syncthreads();
    if (tid < 88) {
        const int c = tid; float h = 0.f, P = 1.f;
        const float* aout = xin;
        if (fin) { for (int jj = 0; jj < j; ++jj) { const float* gp = p.agg + (((size_t)b * 32 + jj) * DR + n * 88 + c) * 2; h = gp[0] * h + gp[1]; } }
        for (int t = 0; t < 128; ++t) { const float av = aout[t * 88 + c], uv = xcu[t * 88 + c]; h = av * h + uv; P *= av; if (fin) xcu[t * 88 + c] = h; }
        if (!fin) { float* gp = p.agg + (((size_t)b * 32 + j) * DR + n * 88 + c) * 2; gp[0] = P; gp[1] = h; }
    }
    if (fin) {
        __syncthreads();
        for (int c = tid; c < 128 * 11; c += 512) {
            const int t = c / 11, cc = c - t * 11;
            bf16_t* gp = p.sgr + (tok0 + t) * DR + n * 88 + cc * 8;
            f32x4 g0, g1; load8f(gp, g0, g1);
            const float* hp = xcu + t * 88 + cc * 8;
            const f32x4 h0 = *(const f32x4*)hp, h1 = *(const f32x4*)(hp + 4);
            store8(gp, g0 * h0, g1 * h1);
        }
    }
    __syncthreads();
}

DEVI void phase_prep_rows(const Params& p) {
    const int tid_ = otid(), wid = tid_ >> 6, lane = tid_ & 63;
    for (int row = blockIdx.x * 8 + wid; row < T; row += gridDim.x * 8) {
        const f32x4* xp = (const f32x4*)(p.x + (size_t)row * 1024);
        float s = 0.f;
#pragma unroll
        for (int i = 0; i < 4; ++i) { const f32x4 vv = xp[i * 64 + lane]; s += (vv[0] * vv[0] + vv[1] * vv[1]) + (vv[2] * vv[2] + vv[3] * vv[3]);
            u32x2 w; w.x = cvtpk(vv[0], vv[1]); w.y = cvtpk(vv[2], vv[3]); *(u32x2*)(p.xb + (size_t)row * 1024 + (i * 64 + lane) * 4) = w; }
        s = wave_sum(s);
        if (lane < 16) p.ssq[(size_t)row * 16 + lane] = (lane == 0) ? s : 0.f;
    }
}
DEVI int win_src_col(int np) {
    const int pn = np >> 8, pp = np & 255, bj = pp >> 7, o = pp & 127;
    if (pn < 8) { const int hsel = o >> 6, i = o & 63; return (pn >= 4 ? 1024 : 0) + (2 * (pn & 3) + hsel) * 128 + bj * 64 + i; }
    if (pn < 12) return 2048 + (pn - 8) * 256 + pp;
    if (pn < 16) { const int hsel = o >> 5, i = o & 31; return 4096 + (4 * (pn - 12) + hsel) * 64 + bj * 32 + i; }
    if (pn < 27) return 5200 + (pn - 16) * 256 + pp;
    if (pn == 27) { if (bj == 0) { if (o < 32) return 5120 + o; if (o < 48) return 5184 + (o - 32); return -1; } else { if (o < 32) return 5152 + o; return -1; } }
    if (pn < 32) return 3072 + (pn - 28) * 256 + pp;
    if (pn < 36) return 8016 + (pn - 32) * 256 + pp;
    return 9040 + (pn - 36) * 256 + pp;
}
DEVI void conv_tile(const float* src, int ldsrc, int K, const float* scale, bf16_t* dst, int n0, int k0, bool winmap, unsigned char* smem) {
    float* tile = (float*)smem;
    const int tid = otid(), w = tid >> 6, lane = tid & 63;
    const int sc = winmap ? win_src_col(n0 + lane) : (n0 + lane);
#pragma unroll
    for (int r = 0; r < 8; ++r) { const int kk = w * 8 + r; float vv = 0.f;
        if (sc >= 0) vv = src[(size_t)(k0 + kk) * ldsrc + sc];
        if (scale) vv *= scale[k0 + kk];
        tile[kk * 65 + lane] = vv; }
    __syncthreads();
    { const int nn = tid >> 3, k8 = (tid & 7) * 8; f32x4 a0, a1;
#pragma unroll
      for (int e = 0; e < 4; ++e) { a0[e] = tile[(k8 + e) * 65 + nn]; a1[e] = tile[(k8 + 4 + e) * 65 + nn]; }
      store8(dst + (size_t)(n0 + nn) * K + k0 + k8, a0, a1); }
    __syncthreads();
}
DEVI void convert_big(const Params& p, int l, unsigned char* smem, int first, int stride) {
    const float* src = p.w_in + (size_t)l * 1024 * NIN; const float* g = p.norm_g + (size_t)l * 1024;
    for (int i = first; i < 160 * 16; i += stride) conv_tile(src, NIN, 1024, g, p.WinT, (i >> 4) * 64, (i & 15) * 64, true, smem);
}
DEVI void convert_small(const Params& p, int l, unsigned char* smem, int first, int stride) {
    bf16_t* W = l ? p.Wsm1 : p.Wsm0;
    for (int i = first; i < 256 + 352 + 256; i += stride) {
        if (i < 256) conv_tile(p.w_oa + (size_t)l * 1024 * 1024, 1024, 1024, nullptr, W + OFF_WA, (i >> 4) * 64, (i & 15) * 64, false, smem);
        else if (i < 608) { const int ii = i - 256; conv_tile(p.w_or + (size_t)l * DR * 1024, 1024, DR, nullptr, W + OFF_WB, (ii / 22) * 64, (ii % 22) * 64, false, smem); }
        else { const int ii = i - 608; conv_tile(p.w_o + (size_t)l * 1024 * 1024, 1024, 1024, nullptr, W + OFF_WO, (ii >> 4) * 64, (ii & 15) * 64, false, smem); }
    }
    for (int e = first * 512 + otid(); e < 2 * 16 * 96 * 96; e += stride * 512) {
        const int k = e % 96, nn = (e / 96) % 96, blk = (e / 9216) % 16, gsel = e / (9216 * 16);
        float vv = 0.f;
        if (k < 88 && nn < 88) vv = (gsel ? p.w_ig : p.w_rg)[(((size_t)l * 16 + blk) * 88 + k) * 88 + nn];
        W[OFF_WG + e] = f2bf(vv);
    }
}
DEVI void phase_final(const Params& p) {
    const int tid_ = otid(), wid = tid_ >> 6, lane = tid_ & 63;
    for (int row = blockIdx.x * 8 + wid; row < T; row += gridDim.x * 8) {
        const float rs = row_rstd(p.ssq, row);
        f32x4* xp = (f32x4*)(p.out + (size_t)row * 1024); const f32x4* gp = (const f32x4*)p.fin_g;
#pragma unroll
        for (int i = 0; i < 4; ++i) { const f32x4 vv = xp[i * 64 + lane], gg = gp[i * 64 + lane]; xp[i * 64 + lane] = vv * rs * gg; }
    }
}

DEVI void run_phase(const Params& p, int ph, unsigned char* smem) {
    LAS unsigned char* lds = (LAS unsigned char*)smem;
    const int G = gridDim.x, c = blockIdx.x;
    if (ph == 0) {
        phase_prep_rows(p);
        convert_big(p, 0, smem, c, G);
        convert_small(p, 0, smem, c, G);
        convert_small(p, 1, smem, c, G);
        return;
    }
    if (ph == NPH - 1) { phase_final(p); return; }
    const int l = (ph - 1) / 6, kind = (ph - 1) % 6;
    const bf16_t* Wsm = l ? p.Wsm1 : p.Wsm0;
    bf16_t* sma = p.iq; bf16_t* smb = p.xr; bf16_t* yag = p.k; bf16_t* merged = p.v; bf16_t* ag = p.q; bf16_t* hg = p.sgr;
    pg8::StaticOrder so;
    if (kind == 0) {
        pg8::Gemm g{p.xb, p.WinT, T, 28 * 256, 1024}; so.init(g.M, g.N, G, c);
        EpiPA1 e{p.ssq, p.pos, p.q, p.k, p.v, p.iq, p.ik, p.xr, p.sgr, p.iw};
        pg8::gemm_phase(lds, g, so, e);
    } else if (kind == 1) {
#ifndef SKIP_IDX
        for (int u = c; u < 2048; u += G) idx_unit(p, u, smem);
#endif
#ifndef SKIP_RNN
        for (int u = c; u < 2048; u += G) rnn_unit(p, l, u, false, smem);
#endif
    } else if (kind == 2) {
#ifndef SKIP_ATT
        phase_attention(p, smem);
#endif
#ifndef SKIP_RNN
        for (int u = c; u < 2048; u += G) rnn_unit(p, l, u, true, smem);
#endif
    } else if (kind == 3) {
        pg8::Gemm g{p.xb, p.WinT + (size_t)28 * 256 * 1024, T, 12 * 256, 1024}; so.init(g.M, g.N, G, c);
        EpiPA2 e{p.ssq, ag, sma, smb};
        pg8::gemm_phase(lds, g, so, e);
    } else if (kind == 4) {
        { pg8::Gemm g{ag, Wsm + OFF_WA, T, 1024, 1024}; so.init(g.M, g.N, G, c);
          EpiPD<0> e{sma, nullptr, yag}; pg8::gemm_phase(lds, g, so, e); }
        { pg8::Gemm g{hg, Wsm + OFF_WB, T, 1024, DR}; so.init(g.M, g.N, G, c);
          EpiPD<1> e{smb, yag, merged}; pg8::gemm_phase(lds, g, so, e); }
        if (l == 0) convert_big(p, 1, smem, c, G);
    } else {
        pg8::Gemm g{merged, Wsm + OFF_WO, T, 1024, 1024}; so.init(g.M, g.N, G, c);
        EpiPE e{l == 0 ? p.x : p.out, p.out, p.xb, p.ssq};
        pg8::gemm_phase(lds, g, so, e);
    }
}

__global__ void __launch_bounds__(512, 2) hybrid_fwd(Params p, int ph_lo, int ph_hi) {
    extern __shared__ __attribute__((aligned(16))) unsigned char smem[];
    for (int ph = ph_lo; ph < ph_hi; ++ph) {
        if (ph > ph_lo) cg::this_grid().sync();
        run_phase(p, ph, smem);
    }
}

extern "C" void kernel_launch(void* const* d_in, const int* in_sizes, int n_in, void* d_out, int out_size, void* d_ws, size_t ws_size, hipStream_t stream) {
    static int grid = 0;
    size_t off = 0; auto take = [&](size_t bytes) { size_t o = off; off += (bytes + 255) & ~(size_t)255; return o; };
    const size_t o_WinT = take((size_t)10240 * 1024 * 2), o_W0 = take(WSM_ELEMS * 2), o_W1 = take(WSM_ELEMS * 2);
    const size_t o_xb = take((size_t)T * 1024 * 2), o_ssq = take((size_t)T * 16 * 4);
    const size_t o_q = take((size_t)T * 1024 * 2), o_k = take((size_t)T * 1024 * 2), o_v = take((size_t)T * 1024 * 2), o_iq = take((size_t)T * 1024 * 2);
    const size_t o_ik = take((size_t)T * 64 * 2), o_iw = take((size_t)T * 16 * 4);
    const size_t o_xr = take((size_t)T * DR * 2), o_sgr = take((size_t)T * DR * 2);
    const size_t o_bm = take((size_t)NB * 64 * S * 8), o_agg = take((size_t)NB * 32 * DR * 2 * 4);
    if (grid == 0) {
        if (n_in != 15 || out_size != T * 1024 || ws_size < off) { fprintf(stderr, "kernel_launch: unexpected shapes / workspace (n_in %d out %d ws %zu need %zu)\n", n_in, out_size, ws_size, off); grid = -1; return; }
        int dev = 0, cus = 0, per_cu = 0;
        (void)hipGetDevice(&dev); (void)hipDeviceGetAttribute(&cus, hipDeviceAttributeMultiprocessorCount, dev);
        if (hipFuncSetAttribute((const void*)hybrid_fwd, hipFuncAttributeMaxDynamicSharedMemorySize, LDS_BYTES) != hipSuccess) { fprintf(stderr, "kernel_launch: hipFuncSetAttribute failed\n"); grid = -1; return; }
        if (hipOccupancyMaxActiveBlocksPerMultiprocessor(&per_cu, (const void*)hybrid_fwd, 512, LDS_BYTES) != hipSuccess || per_cu < 1) { fprintf(stderr, "kernel_launch: occupancy query failed (%d)\n", per_cu); per_cu = 1; }
        (void)hipGetLastError();
        grid = cus * 1;
        if (grid <= 0) grid = 256;
    }
    if (grid < 0) return;
    Params p{};
    p.x = (const float*)d_in[0]; p.pos = (const int*)d_in[1]; p.norm_g = (const float*)d_in[2]; p.w_in = (const float*)d_in[3];
    p.conv_w = (const float*)d_in[4]; p.conv_b = (const float*)d_in[5]; p.w_rg = (const float*)d_in[6]; p.b_rg = (const float*)d_in[7];
    p.w_ig = (const float*)d_in[8]; p.b_ig = (const float*)d_in[9]; p.lam = (const float*)d_in[10]; p.w_oa = (const float*)d_in[11];
    p.w_or = (const float*)d_in[12]; p.w_o = (const float*)d_in[13]; p.fin_g = (const float*)d_in[14];
    p.out = (float*)d_out;
    unsigned char* ws = (unsigned char*)d_ws;
    p.WinT = (bf16_t*)(ws + o_WinT); p.Wsm0 = (bf16_t*)(ws + o_W0); p.Wsm1 = (bf16_t*)(ws + o_W1);
    p.xb = (bf16_t*)(ws + o_xb); p.ssq = (float*)(ws + o_ssq); p.q = (bf16_t*)(ws + o_q); p.k = (bf16_t*)(ws + o_k); p.v = (bf16_t*)(ws + o_v);
    p.iq = (bf16_t*)(ws + o_iq); p.ik = (bf16_t*)(ws + o_ik); p.iw = (float*)(ws + o_iw); p.xr = (bf16_t*)(ws + o_xr); p.sgr = (bf16_t*)(ws + o_sgr);
    p.bm = (u64*)(ws + o_bm); p.agg = (float*)(ws + o_agg);
#if N_LAUNCH_MODE == 1
    int lo = 0, hi = NPH; void* args[] = {&p, &lo, &hi};
    hipError_t e = hipLaunchCooperativeKernel((const void*)hybrid_fwd, dim3(grid), dim3(512), args, LDS_BYTES, stream);
    if (e != hipSuccess) fprintf(stderr, "cooperative launch failed: %s (grid %d)\n", hipGetErrorString(e), grid);
#else
    for (int ph = 0; ph < NPH; ++ph) hipLaunchKernelGGL(hybrid_fwd, dim3(grid), dim3(512), LDS_BYTES, stream, p, ph, ph + 1);
#endif
}
```

```cpp
#include <hip/hip_runtime.h>
#include <hip/hip_cooperative_groups.h>
#include <cstdio>
#include <cstdint>
namespace cg = cooperative_groups;

#ifndef N_LAUNCH_MODE
#define N_LAUNCH_MODE 1
#endif

#ifndef PROBE_REP
#define PROBE_REP 0
#endif
#define DEVI __device__ __forceinline__
#define LAS __attribute__((address_space(3)))
typedef unsigned short bf16_t;
typedef short bf16x8 __attribute__((ext_vector_type(8)));
typedef short s16x4 __attribute__((ext_vector_type(4)));
typedef float f32x2 __attribute__((ext_vector_type(2)));
typedef float f32x4 __attribute__((ext_vector_type(4)));
typedef float f32x16 __attribute__((ext_vector_type(16)));
typedef unsigned u32x2 __attribute__((ext_vector_type(2)));
typedef unsigned u32x4 __attribute__((ext_vector_type(4)));
typedef unsigned long long u64;

constexpr int T = 16384, S = 4096, NB = 4, DM = 1024, DR = 1408, NIN = 10064;
constexpr int LDS_BYTES = 160 * 1024;
constexpr int NPH = 14;

__device__ const float c_inv128[64] = {
1.0f,0.865964353f,0.749894202f,0.649381638f,0.562341332f,0.486967534f,0.421696514f,0.365174115f,0.316227764f,0.273841977f,0.237137377f,0.2053525f,0.177827939f,0.153992653f,0.133352146f,0.115478195f,0.100000001f,0.0865964293f,0.0749894232f,0.0649381652f,0.0562341325f,0.0486967526f,0.0421696492f,0.0365174115f,0.0316227749f,0.0273841955f,0.0237137377f,0.0205352511f,0.0177827943f,0.0153992651f,0.013335214f,0.0115478197f,0.00999999978f,0.00865964312f,0.00749894232f,0.00649381615f,0.00562341325f,0.00486967526f,0.00421696482f,0.00365174119f,0.00316227763f,0.00273841969f,0.00237137382f,0.00205352507f,0.00177827943f,0.00153992651f,0.00133352145f,0.00115478202f,0.00100000005f,0.000865964335f,0.000749894185f,0.000649381604f,0.000562341302f,0.000486967532f,0.000421696517f,0.000365174114f,0.000316227757f,0.000273841957f,0.00023713737f,0.00020535251f,0.00017782794f,0.00015399266f,0.00013335215f,0.0001154782f};

constexpr size_t OFF_WA = 0, OFF_WB = (size_t)1024 * 1024, OFF_WO = OFF_WB + (size_t)1024 * 1408, OFF_WG = OFF_WO + (size_t)1024 * 1024, WSM_ELEMS = OFF_WG + (size_t)2 * 16 * 96 * 96;

struct Params {
    const float* x; const int* pos; const float* norm_g; const float* w_in; const float* conv_w; const float* conv_b;
    const float* w_rg; const float* b_rg; const float* w_ig; const float* b_ig; const float* lam;
    const float* w_oa; const float* w_or; const float* w_o; const float* fin_g;
    float* out;
    bf16_t* WinT; bf16_t* Wsm0; bf16_t* Wsm1;
    bf16_t* xb; float* ssq; bf16_t* q; bf16_t* k; bf16_t* v; bf16_t* iq; bf16_t* ik; float* iw; bf16_t* xr; bf16_t* sgr;
    u64* bm; float* agg; unsigned* bar; bf16_t* halo;
};

DEVI unsigned cvtpk(float lo, float hi) { unsigned r; asm volatile("v_cvt_pk_bf16_f32 %0, %1, %2" : "=v"(r) : "v"(lo), "v"(hi)); return r; }
DEVI float bf_lo(unsigned w) { return __uint_as_float(w << 16); }
DEVI float bf_hi(unsigned w) { return __uint_as_float(w & 0xffff0000u); }
DEVI bf16_t f2bf(float f) { return (bf16_t)(cvtpk(f, 0.f) & 0xffffu); }
DEVI float sigmoidf_(float x) { return __builtin_amdgcn_rcpf(1.0f + __expf(-x)); }
DEVI float siluf_(float x) { return x * __builtin_amdgcn_rcpf(1.0f + __expf(-x)); }
DEVI float expm1_small(float x) {
    const float pl = x * (1.0f + x * (0.5f + x * (0.16666667f + x * (0.041666668f + x * 0.0083333338f))));
    float ex = __expf(x) - 1.0f;
    asm volatile("" : "+v"(ex));
    return fabsf(x) < 0.25f ? pl : ex;
}
DEVI int wave_sum_small(int v) {
    int t = 0;
#pragma unroll
    for (int b = 0; b < 7; ++b) t += __popcll(__ballot((v >> b) & 1)) << b;
    return t;
}
DEVI int otid() { int t = threadIdx.x; asm volatile("" : "+v"(t)); return t; }
DEVI float wave_sum(float s) {
#pragma unroll
    for (int o = 32; o > 0; o >>= 1) s += __shfl_xor(s, o);
    return s;
}
DEVI float row_rstd(const float* ssq, int row) {
    const f32x4* p = (const f32x4*)(ssq + (size_t)row * 16);
    const f32x4 a = p[0], b = p[1], c = p[2], d = p[3];
    const float s = ((a[0] + a[1]) + (a[2] + a[3])) + ((b[0] + b[1]) + (b[2] + b[3])) + ((c[0] + c[1]) + (c[2] + c[3])) + ((d[0] + d[1]) + (d[2] + d[3]));
    return rsqrtf(s * (1.0f / 1024.0f) + 1e-6f);
}

namespace pg8 {
constexpr int BM = 256, BK = 64, HALF = 128, HTB = HALF * BK * 2, STAGE_BYTES = 8 * HTB, NXCD = 8, WGM = 8;
DEVI int lds_byte(int r, int c) { const int st = (r >> 4) * 2 + (c >> 5), rr = r & 15, cc = c & 31, ob = rr * 64 + cc * 2; return st * 1024 + (ob ^ (((ob >> 9) & 1) << 5)); }
DEVI void stage_rc(int b, int& R, int& C) { const int st = b / 1024, sb = b % 1024, swz = sb ^ (((sb >> 9) & 1) << 5); R = (st >> 1) * 16 + swz / 64; C = (st & 1) * 32 + (swz % 64) / 2; }
DEVI int perm32(int rho) { const int n = rho >> 4, i = rho & 15; return 8 * (i >> 2) + 4 * n + (i & 3); }
struct Unit { int pm, pn; };
struct Gemm { const bf16_t* A; const bf16_t* Bt; int M, N, K; };
struct StaticOrder {
    int nM, nN, nwg, G, c;
    DEVI void init(int M, int N, int G_, int c_) { nM = M / BM; nN = N / BM; nwg = nM * nN; G = G_; c = c_; }
    DEVI bool next(int i, Unit& u) const {
        const long L = (long)i * G + c; if (L >= nwg) return false;
        int wgid = (int)L; { const int q = nwg / NXCD, r = nwg % NXCD, xcd = wgid % NXCD, off = wgid / NXCD; wgid = (xcd < r ? xcd * (q + 1) : r * (q + 1) + (xcd - r) * q) + off; }
        const int nig = WGM * nN, gid = wgid / nig, fm = gid * WGM, gsz = (nM - fm) < WGM ? (nM - fm) : WGM;
        u.pm = fm + ((wgid % nig) % gsz); u.pn = (wgid % nig) / gsz; return true;
    }
    DEVI void a_ready(const Unit&) const {}
    DEVI void done(const Unit&) const {}
};

template <class Epi, class Sched>
DEVI void gemm_phase(LAS unsigned char* lds, const Gemm g, const Sched& S, const Epi& E) {
    const int tid = otid(), wid = __builtin_amdgcn_readfirstlane(tid >> 6), lane = tid & 63, wr = wid >> 2, wc = wid & 3, fr = lane & 15, fq = lane >> 4;
    const int K = g.K, nt = K / BK;
    unsigned voffA[2], voffB[2];
#pragma unroll
    for (int i = 0; i < 2; ++i) { int R, C; stage_rc(tid * 16 + i * 8192, R, C); const int Rb = Epi::PERM ? ((R & ~31) + perm32(R & 31)) : R;
        voffA[i] = (unsigned)(R * K + C) * 2u; voffB[i] = (unsigned)(Rb * K + C) * 2u; }
    const size_t kstep = (size_t)(BK * 2);
    const size_t hstep = (size_t)HALF * K * 2;
    const size_t tstep = 2 * hstep;
    const unsigned ldsw = (unsigned)wid * 1024u;
    const int aoff = lds_byte(wr * 64 + fr, fq * 8), boff = lds_byte(wc * 32 + fr, fq * 8);
#define PG8_SA(b, h) (((b) * 2 + (h)) * HTB)
#define PG8_SB(b, h) ((4 + (b) * 2 + (h)) * HTB)
#define PG8_STAGE(bufoff, gbase, voff) do { _Pragma("unroll") for (int _i = 0; _i < 2; ++_i) \
        __builtin_amdgcn_global_load_lds((const unsigned*)((const char*)(gbase) + (voff)[_i]), (LAS unsigned*)(lds + (bufoff) + ldsw + _i * 8192), 16, 0, 0); } while (0)
#define PG8_LDA(dst, b, h) do { _Pragma("unroll") for (int m = 0; m < 4; ++m) _Pragma("unroll") for (int k = 0; k < 2; ++k) dst[m][k] = *(const LAS bf16x8*)(lds + PG8_SA(b, h) + aoff + m * 2048 + k * 1024); } while (0)
#define PG8_LDB(dst, b, h) do { _Pragma("unroll") for (int n = 0; n < 2; ++n) _Pragma("unroll") for (int k = 0; k < 2; ++k) dst[n][k] = *(const LAS bf16x8*)(lds + PG8_SB(b, h) + boff + n * 2048 + k * 1024); } while (0)
#define PG8_MMA(ai, bj, At, Bt) do { __builtin_amdgcn_s_setprio(1); _Pragma("unroll") for (int m = 0; m < 4; ++m) _Pragma("unroll") for (int n = 0; n < 2; ++n) _Pragma("unroll") for (int k = 0; k < 2; ++k) \
        acc[ai][bj][m][n] = __builtin_amdgcn_mfma_f32_16x16x32_bf16(Bt[n][k], At[m][k], acc[ai][bj][m][n], 0, 0, 0); __builtin_amdgcn_s_setprio(0); } while (0)
#define PG8_WAIT_V(n) asm volatile("s_waitcnt vmcnt(" #n ")" ::: "memory")
#define PG8_WAIT_L(n) asm volatile("s_waitcnt lgkmcnt(" #n ")" ::: "memory")
#define PG8_BAR __builtin_amdgcn_s_barrier()
#define PG8_SCHED __builtin_amdgcn_sched_barrier(0)
    Unit cur, nxt; int ui = 0;
    if (!S.next(0, cur)) return;
    f32x4 acc[2][2][4][2];
#pragma unroll
    for (int a = 0; a < 2; ++a)
#pragma unroll
        for (int b = 0; b < 2; ++b)
#pragma unroll
            for (int m = 0; m < 4; ++m)
#pragma unroll
                for (int n = 0; n < 2; ++n) acc[a][b][m][n] = (f32x4){0.f, 0.f, 0.f, 0.f};
    bf16x8 At[4][2], B0[2][2], B1[2][2];
    const char* cA = (const char*)g.A + (size_t)cur.pm * tstep; const char* cB = (const char*)g.Bt + (size_t)cur.pn * tstep;
    S.a_ready(cur);
    PG8_STAGE(PG8_SB(0, 0), cB, voffB); PG8_STAGE(PG8_SA(0, 0), cA, voffA); PG8_STAGE(PG8_SB(0, 1), cB + hstep, voffB); PG8_STAGE(PG8_SA(0, 1), cA + hstep, voffA);
    if (wr == 1) PG8_BAR;
    PG8_WAIT_V(4); PG8_BAR;
    PG8_STAGE(PG8_SB(1, 0), cB + kstep, voffB); PG8_STAGE(PG8_SA(1, 0), cA + kstep, voffA); PG8_STAGE(PG8_SB(1, 1), cB + hstep + kstep, voffB);
    PG8_WAIT_V(6); PG8_BAR;
    for (;;) {
        const bool has_next = S.next(ui + 1, nxt);
        const char* nA = has_next ? (const char*)g.A + (size_t)nxt.pm * tstep : cA; const char* nB = has_next ? (const char*)g.Bt + (size_t)nxt.pn * tstep : cB;
        for (int t = 0; t < nt; t += 2) {
            const bool last = (t == nt - 2);
            const char* a1 = cA + (size_t)(t + 1) * kstep;
            const char* a2 = last ? nA : cA + (size_t)(t + 2) * kstep; const char* b2 = last ? nB : cB + (size_t)(t + 2) * kstep;
            const char* a3 = a2 + kstep; const char* b3 = b2 + kstep;
            if (last && has_next) S.a_ready(nxt);
            PG8_LDB(B0, 0, 0); PG8_SCHED; PG8_LDA(At, 0, 0); PG8_STAGE(PG8_SA(1, 1), a1 + hstep, voffA);
            PG8_WAIT_L(8); PG8_BAR; PG8_WAIT_L(0); PG8_MMA(0, 0, At, B0); PG8_BAR; PG8_SCHED;
            PG8_LDB(B1, 0, 1); PG8_STAGE(PG8_SB(0, 0), b2, voffB);
            PG8_BAR; PG8_WAIT_L(0); PG8_MMA(0, 1, At, B1); PG8_BAR;
            PG8_LDA(At, 0, 1); PG8_STAGE(PG8_SA(0, 0), a2, voffA);
            PG8_BAR; PG8_WAIT_L(0); PG8_MMA(1, 0, At, B0); PG8_BAR; PG8_SCHED;
            PG8_STAGE(PG8_SB(0, 1), b2 + hstep, voffB);
            PG8_WAIT_V(6); PG8_BAR; PG8_MMA(1, 1, At, B1); PG8_BAR;
            PG8_LDB(B0, 1, 0); PG8_SCHED; PG8_LDA(At, 1, 0); PG8_STAGE(PG8_SA(0, 1), a2 + hstep, voffA);
            PG8_WAIT_L(8); PG8_BAR; PG8_WAIT_L(0); PG8_MMA(0, 0, At, B0); PG8_BAR; PG8_SCHED;
            PG8_LDB(B1, 1, 1); PG8_STAGE(PG8_SB(1, 0), b3, voffB);
            PG8_BAR; PG8_WAIT_L(0); PG8_MMA(0, 1, At, B1); PG8_BAR;
            PG8_LDA(At, 1, 1); PG8_STAGE(PG8_SA(1, 0), a3, voffA);
            PG8_BAR; PG8_WAIT_L(0); PG8_MMA(1, 0, At, B0); PG8_BAR; PG8_SCHED;
            PG8_STAGE(PG8_SB(1, 1), b3 + hstep, voffB);
            PG8_WAIT_V(6); PG8_BAR; PG8_MMA(1, 1, At, B1); PG8_BAR;
        }
        E(acc, cur, ui, wr, wc, fr, fq); S.done(cur);
        if (!has_next) break;
#pragma unroll
        for (int a = 0; a < 2; ++a)
#pragma unroll
            for (int b = 0; b < 2; ++b)
#pragma unroll
                for (int m = 0; m < 4; ++m)
#pragma unroll
                    for (int n = 0; n < 2; ++n) acc[a][b][m][n] = (f32x4){0.f, 0.f, 0.f, 0.f};
        cur = nxt; cA = nA; cB = nB; ++ui;
    }
    PG8_WAIT_V(0);
    if (wr == 0) PG8_BAR;
    PG8_BAR;
#undef PG8_SA
#undef PG8_SB
#undef PG8_STAGE
#undef PG8_LDA
#undef PG8_LDB
#undef PG8_MMA
#undef PG8_WAIT_V
#undef PG8_WAIT_L
#undef PG8_BAR
#undef PG8_SCHED
}
}
using pg8::Unit;

constexpr int RS_OFF = 131072;
template <class Sched> DEVI void fill_rstd(const float* ssq, const int* pos, const Sched& S, unsigned char* smem) {
    float* rs = (float*)(smem + RS_OFF);
    const int tid = otid(), w = tid >> 6, lane = tid & 63;
    Unit u;
    if (S.next(w, u)) {
#pragma unroll
        for (int rr = 0; rr < 4; rr += 2) {
            const int r0 = lane + 64 * rr, r1 = r0 + 64;
            const f32x4* s0 = (const f32x4*)(ssq + (size_t)(u.pm * 256 + r0) * 16); const f32x4* s1 = (const f32x4*)(ssq + (size_t)(u.pm * 256 + r1) * 16);
            const f32x4 a = s0[0], b = s0[1], c = s0[2], d = s0[3], e = s1[0], f = s1[1], g = s1[2], h = s1[3];
            const int p0 = pos[u.pm * 256 + r0], p1 = pos[u.pm * 256 + r1];
            const float sm0 = ((a[0] + a[1]) + (a[2] + a[3])) + ((b[0] + b[1]) + (b[2] + b[3])) + ((c[0] + c[1]) + (c[2] + c[3])) + ((d[0] + d[1]) + (d[2] + d[3]));
            const float sm1 = ((e[0] + e[1]) + (e[2] + e[3])) + ((f[0] + f[1]) + (f[2] + f[3])) + ((g[0] + g[1]) + (g[2] + g[3])) + ((h[0] + h[1]) + (h[2] + h[3]));
            rs[w * 256 + r0] = rsqrtf(sm0 * (1.0f / 1024.0f) + 1e-6f); rs[w * 256 + r1] = rsqrtf(sm1 * (1.0f / 1024.0f) + 1e-6f);
            rs[2048 + w * 256 + r0] = (float)p0; rs[2048 + w * 256 + r1] = (float)p1;
        }
    }
    __syncthreads();
}
DEVI void store8(bf16_t* p, const f32x4& a, const f32x4& b) { u32x4 w; w.x = cvtpk(a[0], a[1]); w.y = cvtpk(a[2], a[3]); w.z = cvtpk(b[0], b[1]); w.w = cvtpk(b[2], b[3]); *(u32x4*)p = w; }
DEVI void load8f(const bf16_t* p, f32x4& a, f32x4& b) { const u32x4 w = *(const u32x4*)p; a = (f32x4){bf_lo(w.x), bf_hi(w.x), bf_lo(w.y), bf_hi(w.y)}; b = (f32x4){bf_lo(w.z), bf_hi(w.z), bf_lo(w.w), bf_hi(w.w)}; }

struct EpiPA1 {
    static constexpr bool PERM = true;
    const float* rsl; const int* pos; bf16_t* q; bf16_t* k; bf16_t* v; bf16_t* iq; bf16_t* ik; bf16_t* xr; bf16_t* sgr; float* iw; bf16_t* halo;
    DEVI void operator()(const f32x4 (&acc)[2][2][4][2], const Unit& u, int ui, int wr, int wc, int fr, int fq) const {
        const int pn = u.pn, row0 = u.pm * 256 + wr * 64 + fr, o = wc * 32 + 8 * fq;
        const bool rope = (pn < 8) || (pn >= 12 && pn < 16) || (pn == 27);
        if (rope) {
            bf16_t* dst; int ld, c1, c2, fi, fs; bool act = true, isw = false;
            if (pn < 8) { const int hsel = o >> 6, i0 = o & 63, head = 2 * (pn & 3) + hsel; dst = pn < 4 ? q : k; ld = 1024; c1 = head * 128 + i0; c2 = c1 + 64; fi = i0; fs = 1; }
            else if (pn < 16) { const int hsel = o >> 5, i0 = o & 31, head = 4 * (pn - 12) + hsel; dst = iq; ld = 1024; c1 = head * 64 + i0; c2 = c1 + 32; fi = 2 * i0; fs = 2; }
            else { dst = ik; ld = 64; c1 = o & 31; c2 = c1 + 32; fi = 2 * (o & 31); fs = 2; act = (wc == 0); isw = (wc == 1 && fq < 2); }
            float inv[8];
#pragma unroll
            for (int e = 0; e < 8; ++e) inv[e] = c_inv128[(fi + fs * e) & 63] * 0.15915494309189535f;
#pragma unroll
            for (int ai = 0; ai < 2; ++ai)
#pragma unroll
                for (int m = 0; m < 4; ++m) {
                    const int row = row0 + ai * 128 + m * 16; const float rs = rsl[ui * 256 + (row & 255)];
                    if (act) {
                        const float ps = rsl[2048 + ui * 256 + (row & 255)];
                        f32x4 o1[2], o2[2];
#pragma unroll
                        for (int n = 0; n < 2; ++n)
#pragma unroll
                            for (int j = 0; j < 4; ++j) {
                                const float x1 = acc[ai][0][m][n][j] * rs, x2 = acc[ai][1][m][n][j] * rs;
                                const float rev = __builtin_amdgcn_fractf(ps * inv[4 * n + j]);
                                const float sn = __builtin_amdgcn_sinf(rev), cs = __builtin_amdgcn_cosf(rev);
                                o1[n][j] = x1 * cs - x2 * sn; o2[n][j] = x2 * cs + x1 * sn;
                            }
                        store8(dst + (size_t)row * ld + c1, o1[0], o1[1]); store8(dst + (size_t)row * ld + c2, o2[0], o2[1]);
                    } else if (isw) {
                        const float sc = rs * 0.03125f;
                        float* wp = iw + (size_t)row * 16 + 8 * fq;
                        *(f32x4*)wp = acc[ai][0][m][0] * sc; *(f32x4*)(wp + 4) = acc[ai][0][m][1] * sc;
                    }
                }
        } else {
#pragma unroll
            for (int ai = 0; ai < 2; ++ai)
#pragma unroll
                for (int m = 0; m < 4; ++m) {
                    const int row = row0 + ai * 128 + m * 16; const float rs = rsl[ui * 256 + (row & 255)];
#pragma unroll
                    for (int bj = 0; bj < 2; ++bj) {
                        f32x4 a0 = acc[ai][bj][m][0] * rs, a1 = acc[ai][bj][m][1] * rs;
                        if (pn < 12) { store8(v + (size_t)row * 1024 + (pn - 8) * 256 + bj * 128 + o, a0, a1); }
                        else { const int gc = (pn - 16) * 256 + bj * 128 + o;
                            if (gc < DR) { store8(xr + (size_t)row * DR + gc, a0, a1);
                                if ((row & 1023) >= 1021) store8(halo + ((size_t)(row >> 10) * 3 + ((row & 1023) - 1021)) * DR + gc, a0, a1); }
                            else {
#pragma unroll
                                for (int j = 0; j < 4; ++j) { a0[j] = siluf_(a0[j]); a1[j] = siluf_(a1[j]); }
                                store8(sgr + (size_t)row * DR + gc - DR, a0, a1); } }
                    }
                }
        }
    }
};
struct EpiTriv {
    static constexpr bool PERM = true;
    bf16_t* v;
    DEVI void operator()(const f32x4 (&acc)[2][2][4][2], const Unit& u, int ui, int wr, int wc, int fr, int fq) const {
        const int row0 = u.pm * 256 + wr * 64 + fr, o = wc * 32 + 8 * fq;
#pragma unroll
        for (int ai = 0; ai < 2; ++ai)
#pragma unroll
            for (int m = 0; m < 4; ++m) { const int row = row0 + ai * 128 + m * 16;
#pragma unroll
                for (int bj = 0; bj < 2; ++bj) store8(v + (size_t)row * 1024 + (u.pn & 3) * 256 + bj * 128 + o, acc[ai][bj][m][0], acc[ai][bj][m][1]); }
    }
};
struct EpiPA2 {
    static constexpr bool PERM = true;
    const float* rsl; bf16_t* ag; bf16_t* sma; bf16_t* smb;
    DEVI void operator()(const f32x4 (&acc)[2][2][4][2], const Unit& u, int ui, int wr, int wc, int fr, int fq) const {
        const int pn = u.pn, row0 = u.pm * 256 + wr * 64 + fr, o = wc * 32 + 8 * fq;
#pragma unroll
        for (int ai = 0; ai < 2; ++ai) {
            u32x4 gv[4][2];
            if (pn < 4) {
#pragma unroll
                for (int m = 0; m < 4; ++m)
#pragma unroll
                    for (int bj = 0; bj < 2; ++bj) gv[m][bj] = *(const u32x4*)(ag + (size_t)(row0 + ai * 128 + m * 16) * 1024 + (pn & 3) * 256 + bj * 128 + o);
            }
#pragma unroll
            for (int m = 0; m < 4; ++m) {
                const int row = row0 + ai * 128 + m * 16; const float rs = rsl[ui * 256 + (row & 255)];
#pragma unroll
                for (int bj = 0; bj < 2; ++bj) {
                    f32x4 a0 = acc[ai][bj][m][0] * rs, a1 = acc[ai][bj][m][1] * rs;
                    const size_t off = (size_t)row * 1024 + (pn & 3) * 256 + bj * 128 + o;
                    if (pn < 4) { const u32x4 w = gv[m][bj];
                        const f32x4 g0 = {bf_lo(w.x), bf_hi(w.x), bf_lo(w.y), bf_hi(w.y)}, g1 = {bf_lo(w.z), bf_hi(w.z), bf_lo(w.w), bf_hi(w.w)};
#pragma unroll
                        for (int j = 0; j < 4; ++j) { a0[j] = siluf_(a0[j]) * g0[j]; a1[j] = siluf_(a1[j]) * g1[j]; }
                        store8(ag + off, a0, a1); }
                    else {
#pragma unroll
                        for (int j = 0; j < 4; ++j) { a0[j] = sigmoidf_(a0[j]); a1[j] = sigmoidf_(a1[j]); }
                        store8((pn < 8 ? sma : smb) + off, a0, a1); }
                }
            }
        }
    }
};
template <int MODE> struct EpiPD {
    static constexpr bool PERM = true;
    const bf16_t* gate; const bf16_t* yin; bf16_t* outp;
    DEVI void operator()(const f32x4 (&acc)[2][2][4][2], const Unit& u, int ui, int wr, int wc, int fr, int fq) const {
        const int row0 = u.pm * 256 + wr * 64 + fr, o = wc * 32 + 8 * fq;
#pragma unroll
        for (int ai = 0; ai < 2; ++ai) {
            u32x4 gv[4][2], yv[4][2];
#pragma unroll
            for (int m = 0; m < 4; ++m)
#pragma unroll
                for (int bj = 0; bj < 2; ++bj) { const size_t off = (size_t)(row0 + ai * 128 + m * 16) * 1024 + u.pn * 256 + bj * 128 + o;
                    gv[m][bj] = *(const u32x4*)(gate + off); if (MODE == 1) yv[m][bj] = *(const u32x4*)(yin + off); }
#pragma unroll
            for (int m = 0; m < 4; ++m)
#pragma unroll
                for (int bj = 0; bj < 2; ++bj) {
                    const size_t off = (size_t)(row0 + ai * 128 + m * 16) * 1024 + u.pn * 256 + bj * 128 + o;
                    const u32x4 w = gv[m][bj];
                    const f32x4 g0 = {bf_lo(w.x), bf_hi(w.x), bf_lo(w.y), bf_hi(w.y)}, g1 = {bf_lo(w.z), bf_hi(w.z), bf_lo(w.w), bf_hi(w.w)};
                    f32x4 a0 = acc[ai][bj][m][0] * g0, a1 = acc[ai][bj][m][1] * g1;
                    if (MODE == 1) { const u32x4 y = yv[m][bj];
                        a0 += (f32x4){bf_lo(y.x), bf_hi(y.x), bf_lo(y.y), bf_hi(y.y)}; a1 += (f32x4){bf_lo(y.z), bf_hi(y.z), bf_lo(y.w), bf_hi(y.w)}; }
                    store8(outp + off, a0, a1);
                }
        }
    }
};
struct EpiPE {
    static constexpr bool PERM = false;
    const float* xin; float* xout; bf16_t* xb; float* ssq;
    DEVI void operator()(const f32x4 (&acc)[2][2][4][2], const Unit& u, int ui, int wr, int wc, int fr, int fq) const {
        const int row0 = u.pm * 256 + wr * 64 + fr, col0 = u.pn * 256 + wc * 32 + 4 * fq;
#pragma unroll
        for (int ai = 0; ai < 2; ++ai) {
            f32x4 xv[4][2][2];
#pragma unroll
            for (int m = 0; m < 4; ++m)
#pragma unroll
                for (int bj = 0; bj < 2; ++bj)
#pragma unroll
                    for (int n = 0; n < 2; ++n) xv[m][bj][n] = *(const f32x4*)(xin + (size_t)(row0 + ai * 128 + m * 16) * 1024 + col0 + bj * 128 + n * 16);
#pragma unroll
            for (int m = 0; m < 4; ++m) {
                const int row = row0 + ai * 128 + m * 16; float s = 0.f;
#pragma unroll
                for (int bj = 0; bj < 2; ++bj)
#pragma unroll
                    for (int n = 0; n < 2; ++n) {
                        const size_t off = (size_t)row * 1024 + col0 + bj * 128 + n * 16;
                        const f32x4 x2 = xv[m][bj][n] + acc[ai][bj][m][n];
                        *(f32x4*)(xout + off) = x2;
                        u32x2 w; w.x = cvtpk(x2[0], x2[1]); w.y = cvtpk(x2[2], x2[3]); *(u32x2*)(xb + off) = w;
                        s += (x2[0] * x2[0] + x2[1] * x2[1]) + (x2[2] * x2[2] + x2[3] * x2[3]);
                    }
                s += __shfl_xor(s, 16); s += __shfl_xor(s, 32);
                if (fq == 0) ssq[(size_t)row * 16 + u.pn * 4 + wc] = s;
            }
        }
    }
};

namespace at {
constexpr int D = 128, RS = 1024;
constexpr float SCALE = 0.08838834764831845f;
constexpr float THR = 8.f;
constexpr int NW = 8, QBLK = 32, KVBLK = 64, QB = NW * QBLK;
constexpr int SHM_V = KVBLK * D * 2, SHM_K = KVBLK * D * 2;
#define KSWZ(row, colB) ((row) * 256 + ((colB) ^ (((row) & 7) << 4)))
#define SBAR() __builtin_amdgcn_sched_barrier(0)
DEVI int v_st(int k, int c) { const int kk = (k & ~0xC) | ((k & 4) << 1) | ((k & 8) >> 1); return ((kk >> 3) * 4 + (c >> 5)) * 512 + ((kk & 7) * 32 + (c & 31)) * 2; }
DEVI int v_rd_base(int lane) { return ((lane & 3) << 3) | (((lane >> 2) & 3) << 6) | (((lane >> 4) & 1) << 5) | (((lane >> 5) & 1) << 8); }
constexpr int v_rd_off(int d0, int ks, int half) { return d0 * 512 + ks * 4096 + half * 2048; }
DEVI int crow(int r, int hi) { return (r & 3) + 8 * (r >> 2) + 4 * hi; }
DEVI bf16x8 load8(const bf16_t* p) { return *reinterpret_cast<const bf16x8*>(p); }
DEVI void mask_bits(f32x16& p0, f32x16& p1, u64 mw, int hi) {
    const float NEG = -__builtin_inff();
    const unsigned lo = (unsigned)mw >> (4 * hi), hh = (unsigned)(mw >> 32) >> (4 * hi);
#pragma unroll
    for (int r = 0; r < 16; ++r) {
        const int c = (r & 3) + 8 * (r >> 2);
        if (!((lo >> c) & 1u)) p0[r] = NEG;
        if (!((hh >> c) & 1u)) p1[r] = NEG;
    }
}
DEVI void partialSM(f32x16& p0, f32x16& p1, float& m_reg, float& mn, float& alpha) {
    float pmax = p0[0];
#pragma unroll
    for (int r = 1; r < 16; ++r) pmax = fmaxf(pmax, p0[r]);
#pragma unroll
    for (int r = 0; r < 16; ++r) pmax = fmaxf(pmax, p1[r]);
    { auto rr = __builtin_amdgcn_permlane32_swap(__float_as_uint(pmax), __float_as_uint(pmax), false, false);
      pmax = fmaxf(__uint_as_float(rr[0]), __uint_as_float(rr[1])); }
    constexpr float C2 = 1.4426950408889634f * SCALE;
    if (__builtin_expect(__all((pmax - m_reg) * SCALE <= THR), 1)) { mn = m_reg; alpha = 1.f; }
    else { mn = fmaxf(m_reg, pmax); alpha = __builtin_amdgcn_exp2f((m_reg - mn) * C2); m_reg = mn; }
    const float mnL = -mn * C2;
#pragma unroll
    for (int r = 0; r < 16; ++r) p0[r] = fmaf(p0[r], C2, mnL);
#pragma unroll
    for (int r = 0; r < 16; ++r) p1[r] = fmaf(p1[r], C2, mnL);
#pragma unroll
    for (int r = 0; r < 16; ++r) p0[r] = __builtin_amdgcn_exp2f(p0[r]);
}
DEVI void finishSM(f32x16& p0, f32x16& p1, float alpha, float& l_reg, bf16x8& pa0, bf16x8& pa1, bf16x8& pa2, bf16x8& pa3) {
#pragma unroll
    for (int r = 0; r < 16; ++r) p1[r] = __builtin_amdgcn_exp2f(p1[r]);
    float ps = 0;
#pragma unroll
    for (int r = 0; r < 16; ++r) ps += p0[r];
#pragma unroll
    for (int r = 0; r < 16; ++r) ps += p1[r];
    { auto rr = __builtin_amdgcn_permlane32_swap(__float_as_uint(ps), __float_as_uint(ps), false, false);
      ps = __uint_as_float(rr[0]) + __uint_as_float(rr[1]); }
    l_reg = l_reg * alpha + ps;
#define PK4(P, B_, OUT) do { unsigned a0 = cvtpk(P[B_+0], P[B_+1]), a1 = cvtpk(P[B_+2], P[B_+3]);                          \
        unsigned b0 = cvtpk(P[B_+4], P[B_+5]), b1 = cvtpk(P[B_+6], P[B_+7]);                                             \
        auto r0 = __builtin_amdgcn_permlane32_swap(a0, b0, false, false); auto r1 = __builtin_amdgcn_permlane32_swap(a1, b1, false, false); \
        u32x4 w = {r0[0], r1[0], r0[1], r1[1]}; OUT = *reinterpret_cast<bf16x8*>(&w); } while (0)
    PK4(p0, 0, pa0); PK4(p0, 8, pa1); PK4(p1, 0, pa2); PK4(p1, 8, pa3);
#undef PK4
}
template <int KB>
DEVI void qkt(f32x16& p0, f32x16& p1, const char* K_lds, int r32, int hi, const LAS unsigned char* qb) {
    p0 = f32x16{}; p1 = f32x16{};
    const char* kb[4];
#pragma unroll
    for (int dd = 0; dd < 4; ++dd) kb[dd] = K_lds + KB * SHM_K + KSWZ(r32, (dd * 16 + hi * 8) * 2);
#pragma unroll
    for (int d0 = 0; d0 < 8; ++d0) { const char* a = kb[d0 & 3] + (d0 >> 2) * 128;
        bf16x8 b0 = *reinterpret_cast<const bf16x8*>(a);
        bf16x8 b1 = *reinterpret_cast<const bf16x8*>(a + 32 * 256);
        const bf16x8 qf = *(const LAS bf16x8*)(qb + d0 * 1024);
        p0 = __builtin_amdgcn_mfma_f32_32x32x16_bf16(b0, qf, p0, 0, 0, 0);
        p1 = __builtin_amdgcn_mfma_f32_32x32x16_bf16(b1, qf, p1, 0, 0, 0); }
}
template <int VB>
DEVI void pv_tile(f32x16* o, int vb0, bf16x8 pa0, bf16x8 pa1, bf16x8 pa2, bf16x8 pa3) {
#define TRRD(dst, off) asm volatile("ds_read_b64_tr_b16 %0, %1 offset:%2" : "=&v"(dst) : "v"(vb0), "i"(off) : "memory")
#define PV_D0(d0) do { s16x4 l0, l1, l2, l3, h0, h1, h2, h3; constexpr int b_ = VB * SHM_V + v_rd_off(d0, 0, 0); \
        TRRD(l0, b_); TRRD(h0, b_ + 2048); TRRD(l1, b_ + 4096); TRRD(h1, b_ + 6144); TRRD(l2, b_ + 8192); TRRD(h2, b_ + 10240); TRRD(l3, b_ + 12288); TRRD(h3, b_ + 14336); \
        asm volatile("s_waitcnt lgkmcnt(0)" ::: "memory"); SBAR();   \
        o[d0] = __builtin_amdgcn_mfma_f32_32x32x16_bf16(pa0, (bf16x8){l0[0], l0[1], l0[2], l0[3], h0[0], h0[1], h0[2], h0[3]}, o[d0], 0, 0, 0);   \
        o[d0] = __builtin_amdgcn_mfma_f32_32x32x16_bf16(pa1, (bf16x8){l1[0], l1[1], l1[2], l1[3], h1[0], h1[1], h1[2], h1[3]}, o[d0], 0, 0, 0);   \
        o[d0] = __builtin_amdgcn_mfma_f32_32x32x16_bf16(pa2, (bf16x8){l2[0], l2[1], l2[2], l2[3], h2[0], h2[1], h2[2], h2[3]}, o[d0], 0, 0, 0);   \
        o[d0] = __builtin_amdgcn_mfma_f32_32x32x16_bf16(pa3, (bf16x8){l3[0], l3[1], l3[2], l3[3], h3[0], h3[1], h3[2], h3[3]}, o[d0], 0, 0, 0); } while (0)
    PV_D0(0); PV_D0(1); PV_D0(2); PV_D0(3);
#undef PV_D0
#undef TRRD
}
struct BlockRef { const bf16_t* Q; const bf16_t* K; const bf16_t* V; bf16_t* O; const u64* M; int P0; };
struct Stg { bf16x8 st_v0, st_v1, st_k0, st_k1; };
constexpr int MOFF = 2 * SHM_V + 2 * SHM_K + NW * 64 * 4, QOFF = MOFF + 4096;
#define ROW(p, k0, rr) ((p) + (size_t)((k0) + (rr)) * RS + sc)
#define VMW() asm volatile("s_waitcnt vmcnt(0)" ::: "memory")
#define VMWN(n) asm volatile("s_waitcnt vmcnt(%0)" :: "i"(n) : "memory")
#define SLOAD_H(Kp, Vp, k0) do { S.st_v0 = load8(ROW(Vp, k0, sr)); S.st_v1 = load8(ROW(Vp, k0, 32 + sr));              \
                         S.st_k0 = load8(ROW(Kp, k0, sr)); S.st_k1 = load8(ROW(Kp, k0, 32 + sr)); } while (0)
#define SWRITE_HK(bf) do { *(bf16x8*)(K_lds + (bf) * SHM_K + kws) = S.st_k0; *(bf16x8*)(K_lds + (bf) * SHM_K + kws + 32 * 256) = S.st_k1; } while (0)
#define SWRITE_HV(bf) do { *(bf16x8*)(V_lds + (bf) * SHM_V + vst0) = S.st_v0; *(bf16x8*)(V_lds + (bf) * SHM_V + vst1) = S.st_v1; } while (0)
#define SWRITE_H(bf) do { SWRITE_HV(bf); SWRITE_HK(bf); } while (0)
DEVI void attn_block(const BlockRef& cur, char* lds) {
    const int tid = otid(), wid = __builtin_amdgcn_readfirstlane(tid >> 6), lane = tid & 63, r32 = lane & 31, hi = lane >> 5;
    const int NT = (cur.P0 + QB - 1) / KVBLK + 1;
    char* V_lds = lds; char* K_lds = lds + 2 * SHM_V;
    float* ws = (float*)(lds + 2 * SHM_V + 2 * SHM_K) + wid * 64; float* li_l = ws, * al_l = ws + 32;
    float m_reg = -1e30f, l_reg = 0; f32x16 o[4] = {};
    const int sr = tid >> 4, sc = (tid & 15) * 8, vst0 = v_st(sr, sc), vst1 = v_st(32 + sr, sc), kws = KSWZ(sr, sc * 2);
    const int vb0 = (int)(uintptr_t)V_lds + v_rd_base(lane);
    const bf16_t* Kh = cur.K; const bf16_t* Vh = cur.V;
    const char* Mu = (const char*)(cur.M + cur.P0 + wid * QBLK);
    const unsigned lane4 = (unsigned)lane * 4u;
    LAS unsigned char* mlds = (LAS unsigned char*)(lds + MOFF) + wid * 256;
    LAS unsigned char* qb = (LAS unsigned char*)(lds + QOFF) + wid * 8192 + lane * 16;
    Stg S;
#define RESC(a) do { if (__any((a) < 1.f)) { if (hi == 0) al_l[r32] = (a); asm volatile("s_waitcnt lgkmcnt(0)" ::: "memory");              \
                     for (int d_ = 0; d_ < 4; ++d_) for (int r = 0; r < 16; ++r) o[d_][r] *= al_l[crow(r, hi)]; } } while (0)
#define KBASE(t) ((t) * KVBLK)
#define MLOAD(t) do { __builtin_amdgcn_global_load_lds((const unsigned*)(Mu + (size_t)(t) * 32768 + lane4), (LAS unsigned*)(mlds + ((t) & 1) * 2048), 4, 0, 0); } while (0)
#define MASKT(P0_, P1_, t) do { const u64 mw_ = *(const LAS u64*)(mlds + ((t) & 1) * 2048 + r32 * 8); mask_bits(P0_, P1_, mw_, hi); } while (0)
    f32x16 pA0, pA1, pB0, pB1; float mnA, mnB, alA, alB; bf16x8 pa0, pa1, pa2, pa3;
    {
#pragma unroll
        for (int d0 = 0; d0 < 8; ++d0) { const bf16x8 qf = load8(cur.Q + (size_t)(wid * QBLK + r32) * RS + d0 * 16 + hi * 8); *(LAS bf16x8*)(qb + d0 * 1024) = qf; }
        SLOAD_H(Kh, Vh, 0); VMW(); SWRITE_H(0);
    }
    MLOAD(0);
    SLOAD_H(Kh, Vh, KBASE(1));
    __syncthreads();
    SBAR(); qkt<0>(pA0, pA1, K_lds, r32, hi, qb);
    VMWN(4);
    MASKT(pA0, pA1, 0); partialSM(pA0, pA1, m_reg, mnA, alA);
    VMW(); SWRITE_H(1);
    __syncthreads();
#define HALF_STEP(PX0, PX1, mnX, alX, PY0, PY1, alY, t, KB, VB, SB) do {                                                      \
        MLOAD(t);                                                                                                             \
        SBAR(); qkt<KB>(PX0, PX1, K_lds, r32, hi, qb);                                                                       \
        finishSM(PY0, PY1, alY, l_reg, pa0, pa1, pa2, pa3); SBAR();                                                           \
        if ((t) + 1 < NT) { SLOAD_H(Kh, Vh, KBASE((t) + 1)); SBAR(); }                                                        \
        pv_tile<VB>(o, vb0, pa0, pa1, pa2, pa3);                                                                              \
        if ((t) + 1 < NT) VMWN(4); else VMW();                                                                                \
        MASKT(PX0, PX1, t); partialSM(PX0, PX1, m_reg, mnX, alX);                                                             \
        __syncthreads();                                                                                                      \
        if ((t) + 1 < NT) { VMW(); SWRITE_H(SB); }                                                                            \
        RESC(alX); __syncthreads(); } while (0)
    for (int t = 1; t + 1 < NT; t += 2) {
        HALF_STEP(pB0, pB1, mnB, alB, pA0, pA1, alA, t, 1, 0, 0);
        HALF_STEP(pA0, pA1, mnA, alA, pB0, pB1, alB, t + 1, 0, 1, 1);
    }
    const bool even = (NT & 1) == 0;
    if (even) { MLOAD(NT - 1); SBAR(); qkt<1>(pB0, pB1, K_lds, r32, hi, qb); SBAR(); }
    finishSM(pA0, pA1, alA, l_reg, pa0, pa1, pa2, pa3); SBAR();
    pv_tile<0>(o, vb0, pa0, pa1, pa2, pa3);
    if (even) { VMW(); MASKT(pB0, pB1, NT - 1); partialSM(pB0, pB1, m_reg, mnB, alB); __syncthreads(); RESC(alB);
        finishSM(pB0, pB1, alB, l_reg, pa0, pa1, pa2, pa3); SBAR(); pv_tile<1>(o, vb0, pa0, pa1, pa2, pa3); }
    SBAR();
    if (hi == 0) li_l[r32] = l_reg; asm volatile("s_waitcnt lgkmcnt(0)" ::: "memory");
    float rli[16];
#pragma unroll
    for (int r = 0; r < 16; ++r) rli[r] = __builtin_amdgcn_rcpf(li_l[crow(r, hi)]);
    bf16_t* Ow = cur.O + (size_t)(wid * QBLK) * RS;
#pragma unroll
    for (int r = 0; r < 16; ++r) { const int orow = crow(r, hi);
#pragma unroll
        for (int d0 = 0; d0 < 4; ++d0) { const float v = o[d0][r] * rli[r];
            const float vn = __shfl_xor(v, 1);
            if ((r32 & 1) == 0) *(unsigned*)(Ow + (size_t)orow * RS + d0 * 32 + r32) = cvtpk(v, vn); } }
    __syncthreads();
#undef RESC
#undef KBASE
#undef MLOAD
#undef MASKT
#undef HALF_STEP
}
#undef ROW
#undef VMW
#undef VMWN
#undef SLOAD_H
#undef SWRITE_HK
#undef SWRITE_HV
#undef SWRITE_H
}

DEVI at::BlockRef attn_ref(const Params& p, int bh, int qb, bf16_t* obase) {
    const int b = bh >> 3, h = bh & 7; at::BlockRef r;
    const size_t base = (size_t)b * S * 1024 + h * 128;
    r.Q = p.q + base + (size_t)qb * 256 * 1024; r.O = obase + base + (size_t)qb * 256 * 1024;
    r.K = p.k + base; r.V = p.v + base; r.M = p.bm + (size_t)b * 64 * S; r.P0 = qb * 256;
    return r;
}
DEVI void phase_attention(const Params& p, unsigned char* smem, bf16_t* obase) {
    const int total = 256, G = gridDim.x;
    for (int c = blockIdx.x; c < total; c += G) {
        const int L = (G == 256) ? ((c & 7) * 32 + (c >> 3)) : c;
        const int bh = L >> 3, x = L & 7;
        at::attn_block(attn_ref(p, bh, 15 - x, obase), (char*)smem);
        at::attn_block(attn_ref(p, bh, x, obase), (char*)smem);
    }
}

DEVI void idx_cnt8(int& cl, unsigned cand, unsigned k0, unsigned k1, unsigned k2, unsigned k3, unsigned k4, unsigned k5, unsigned k6, unsigned k7) {
    u64 m0, m1, m2, m3, m4, m5, m6, m7;
    asm volatile(
        "v_cmp_le_u32_e64 %[m0], %[c], %[k0]\n\tv_cmp_le_u32_e64 %[m1], %[c], %[k1]\n\tv_cmp_le_u32_e64 %[m2], %[c], %[k2]\n\tv_cmp_le_u32_e64 %[m3], %[c], %[k3]\n\t"
        "v_cmp_le_u32_e64 %[m4], %[c], %[k4]\n\tv_cmp_le_u32_e64 %[m5], %[c], %[k5]\n\tv_cmp_le_u32_e64 %[m6], %[c], %[k6]\n\tv_cmp_le_u32_e64 %[m7], %[c], %[k7]\n\t"
        "v_addc_co_u32_e64 %[cl], %[m0], 0, %[cl], %[m0]\n\tv_addc_co_u32_e64 %[cl], %[m1], 0, %[cl], %[m1]\n\tv_addc_co_u32_e64 %[cl], %[m2], 0, %[cl], %[m2]\n\tv_addc_co_u32_e64 %[cl], %[m3], 0, %[cl], %[m3]\n\t"
        "v_addc_co_u32_e64 %[cl], %[m4], 0, %[cl], %[m4]\n\tv_addc_co_u32_e64 %[cl], %[m5], 0, %[cl], %[m5]\n\tv_addc_co_u32_e64 %[cl], %[m6], 0, %[cl], %[m6]\n\tv_addc_co_u32_e64 %[cl], %[m7], 0, %[cl], %[m7]\n\ts_nop 1"
        : [cl] "+v"(cl), [m0] "=&s"(m0), [m1] "=&s"(m1), [m2] "=&s"(m2), [m3] "=&s"(m3), [m4] "=&s"(m4), [m5] "=&s"(m5), [m6] "=&s"(m6), [m7] "=&s"(m7)
        : [c] "s"(cand), [k0] "v"(k0), [k1] "v"(k1), [k2] "v"(k2), [k3] "v"(k3), [k4] "v"(k4), [k5] "v"(k5), [k6] "v"(k6), [k7] "v"(k7));
}
template <int BASE>
DEVI void idx_emit8(unsigned& mlo, unsigned& mhi, unsigned T_, unsigned k0, unsigned k1, unsigned k2, unsigned k3, unsigned k4, unsigned k5, unsigned k6, unsigned k7) {
    u64 m0, m1, m2, m3, m4, m5, m6, m7;
    asm volatile(
        "v_cmp_lt_u32_e64 %[m0], %[c], %[k0]\n\tv_cmp_lt_u32_e64 %[m1], %[c], %[k1]\n\tv_cmp_lt_u32_e64 %[m2], %[c], %[k2]\n\tv_cmp_lt_u32_e64 %[m3], %[c], %[k3]\n\t"
        "v_cmp_lt_u32_e64 %[m4], %[c], %[k4]\n\tv_cmp_lt_u32_e64 %[m5], %[c], %[k5]\n\tv_cmp_lt_u32_e64 %[m6], %[c], %[k6]\n\tv_cmp_lt_u32_e64 %[m7], %[c], %[k7]\n\ts_nop 3"
        : [m0] "=&s"(m0), [m1] "=&s"(m1), [m2] "=&s"(m2), [m3] "=&s"(m3), [m4] "=&s"(m4), [m5] "=&s"(m5), [m6] "=&s"(m6), [m7] "=&s"(m7)
        : [c] "s"(T_), [k0] "v"(k0), [k1] "v"(k1), [k2] "v"(k2), [k3] "v"(k3), [k4] "v"(k4), [k5] "v"(k5), [k6] "v"(k6), [k7] "v"(k7));
    asm volatile(
        "s_nop 3\n\t"
        "v_writelane_b32 %[lo], %[a0], %[i0]\n\tv_writelane_b32 %[hi], %[b0], %[i0]\n\tv_writelane_b32 %[lo], %[a1], %[i1]\n\tv_writelane_b32 %[hi], %[b1], %[i1]\n\t"
        "v_writelane_b32 %[lo], %[a2], %[i2]\n\tv_writelane_b32 %[hi], %[b2], %[i2]\n\tv_writelane_b32 %[lo], %[a3], %[i3]\n\tv_writelane_b32 %[hi], %[b3], %[i3]\n\t"
        "v_writelane_b32 %[lo], %[a4], %[i4]\n\tv_writelane_b32 %[hi], %[b4], %[i4]\n\tv_writelane_b32 %[lo], %[a5], %[i5]\n\tv_writelane_b32 %[hi], %[b5], %[i5]\n\t"
        "v_writelane_b32 %[lo], %[a6], %[i6]\n\tv_writelane_b32 %[hi], %[b6], %[i6]\n\tv_writelane_b32 %[lo], %[a7], %[i7]\n\tv_writelane_b32 %[hi], %[b7], %[i7]\n\ts_nop 1"
        : [lo] "+v"(mlo), [hi] "+v"(mhi)
        : [a0] "s"((unsigned)m0), [b0] "s"((unsigned)(m0 >> 32)), [a1] "s"((unsigned)m1), [b1] "s"((unsigned)(m1 >> 32)), [a2] "s"((unsigned)m2), [b2] "s"((unsigned)(m2 >> 32)),
          [a3] "s"((unsigned)m3), [b3] "s"((unsigned)(m3 >> 32)), [a4] "s"((unsigned)m4), [b4] "s"((unsigned)(m4 >> 32)), [a5] "s"((unsigned)m5), [b5] "s"((unsigned)(m5 >> 32)),
          [a6] "s"((unsigned)m6), [b6] "s"((unsigned)(m6 >> 32)), [a7] "s"((unsigned)m7), [b7] "s"((unsigned)(m7 >> 32)),
          [i0] "n"(BASE), [i1] "n"(BASE + 1), [i2] "n"(BASE + 2), [i3] "n"(BASE + 3), [i4] "n"(BASE + 4), [i5] "n"(BASE + 5), [i6] "n"(BASE + 6), [i7] "n"(BASE + 7));
}
DEVI int idx_count(const unsigned (&kv)[64], int ni, unsigned cand) {
    int cl = 0;
    cand = (unsigned)__builtin_amdgcn_readfirstlane((int)cand);
#pragma unroll
    for (int g8 = 0; g8 < 8; ++g8) {
        if (g8 * 8 < ni) idx_cnt8(cl, cand, kv[g8 * 8], kv[g8 * 8 + 1], kv[g8 * 8 + 2], kv[g8 * 8 + 3], kv[g8 * 8 + 4], kv[g8 * 8 + 5], kv[g8 * 8 + 6], kv[g8 * 8 + 7]);
    }
    return wave_sum_small(cl);
}
struct IdxPre { u32x4 av[2]; unsigned iv[16]; f32x4 w4v[4]; float wv; bf16x8 b0[4], b1[4], b2[4]; };
DEVI void idx_issue(const Params& p, int u, IdxPre& R) {
    const int tid = otid(), wid = __builtin_amdgcn_readfirstlane(tid >> 6), lane = tid & 63, r32 = lane & 31, hi = lane >> 5;
    const int slot = u & 255, ii = u >> 8, b = ii >> 1, g = (ii & 1) ? 511 - slot : slot, t0 = g * 8;
    const size_t tokb = (size_t)b * S;
    if (t0 + 8 > 256) {
        R.wv = 0.5f * p.iw[(tokb + t0) * 16 + (tid & 127)];
        { const int qq = tid >> 6, d = tid & 63;
          const f32x4* wp = (const f32x4*)(p.iw + (tokb + t0 + qq) * 16); const bf16_t* ip = p.iq + (tokb + t0 + qq) * 1024 + d;
#pragma unroll
          for (int h = 0; h < 16; ++h) R.iv[h] = ip[h * 64];
#pragma unroll
          for (int i = 0; i < 4; ++i) R.w4v[i] = wp[i]; }
#pragma unroll
        for (int e = 0; e < 2; ++e) { const int cid = tid + 512 * e, rt = cid >> 8, s4 = (cid >> 6) & 3, ln = cid & 63, rr = ln & 31, hh = ln >> 5;
            const int qs = (rr >> 2) & 1, hd = (rr & 3) | ((rr >> 3) << 2);
            R.av[e] = *(const u32x4*)(p.iq + (tokb + t0 + 2 * rt + qs) * 1024 + hd * 64 + s4 * 16 + hh * 8); }
        const int ntile = ((t0 + 8 + 63) >> 6) * 2;
        const bf16_t* kbase = p.ik + tokb * 64 + (size_t)r32 * 64 + hi * 8;
#pragma unroll
        for (int s = 0; s < 4; ++s) { const int k0 = wid < ntile ? wid : ntile - 1, k1 = wid + 8 < ntile ? wid + 8 : ntile - 1, k2 = wid + 16 < ntile ? wid + 16 : ntile - 1;
            R.b0[s] = *(const bf16x8*)(kbase + (size_t)k0 * 2048 + s * 16); R.b1[s] = *(const bf16x8*)(kbase + (size_t)k1 * 2048 + s * 16); R.b2[s] = *(const bf16x8*)(kbase + (size_t)k2 * 2048 + s * 16); }
    }
}
DEVI void idx_unit(const Params& p, int u, int un, IdxPre& R, unsigned char* smem) {
    const int tid = otid(), wid = __builtin_amdgcn_readfirstlane(tid >> 6), lane = tid & 63;
    const int slot = u & 255, ii = u >> 8, b = ii >> 1, g = (ii & 1) ? 511 - slot : slot, t0 = g * 8;
    unsigned* keys = (unsigned*)smem;
    u64* wl = (u64*)(smem + 131072);
    float* wvl = (float*)(smem + 135168);
    const size_t tokb = (size_t)b * S;
    const int nk64 = (t0 + 8 + 63) >> 6;
    if (t0 + 8 > 256) {
        const int r32 = lane & 31, hi = lane >> 5;
        bf16_t* lin = (bf16_t*)(smem + 135680);
        if (tid < 128) wvl[tid] = R.wv;
        { const int qq = tid >> 6, d = tid & 63;
          float a = 0.f;
#pragma unroll
          for (int i = 0; i < 4; ++i)
#pragma unroll
              for (int jx = 0; jx < 4; ++jx) a = fmaf(0.5f * R.w4v[i][jx], __uint_as_float(R.iv[4 * i + jx] << 16), a);
          const bf16_t hb = f2bf(a); const float rem = a - __uint_as_float((unsigned)hb << 16);
          lin[qq * 64 + d] = hb; lin[512 + qq * 64 + d] = f2bf(rem); if (tid < 64) lin[1024 + tid] = 0; }
        bf16_t* afl = (bf16_t*)(smem + 137984);
#pragma unroll
        for (int e = 0; e < 2; ++e) *(u32x4*)(afl + (tid + 512 * e) * 8) = R.av[e];
        const int ntile = nk64 * 2;
        const bf16_t* kbase = p.ik + tokb * 64 + (size_t)r32 * 64 + hi * 8;
#define IDX_LOADB(dst, kq) do { const int kk_ = (kq) < ntile ? (kq) : ntile - 1; _Pragma("unroll") for (int s = 0; s < 4; ++s) dst[s] = *(const bf16x8*)(kbase + (size_t)kk_ * 2048 + s * 16); } while (0)
        __syncthreads();
        const bf16_t* afp = afl + lane * 8;
        const bf16_t* a5p = lin + ((r32 < 16) ? ((r32 >> 3) * 512 + (2 * (r32 & 3) + ((r32 >> 2) & 1)) * 64 + hi * 8) : 1024);
#define IDX_AF(rt, s) (*(const bf16x8*)(afp + ((rt) * 4 + (s)) * 512))
#define IDX_M1(bc) do { acc0 = f32x16{}; acc1 = f32x16{}; acc5 = f32x16{};                                                    \
            _Pragma("unroll") for (int s = 0; s < 4; ++s) {                                                                    \
                acc0 = __builtin_amdgcn_mfma_f32_32x32x16_bf16(IDX_AF(0, s), bc[s], acc0, 0, 0, 0);                           \
                acc1 = __builtin_amdgcn_mfma_f32_32x32x16_bf16(IDX_AF(1, s), bc[s], acc1, 0, 0, 0);                           \
                acc5 = __builtin_amdgcn_mfma_f32_32x32x16_bf16(*(const bf16x8*)(a5p + s * 16), bc[s], acc5, 0, 0, 0); }      \
            __builtin_amdgcn_sched_barrier(0); } while (0)
#define IDX_M2(bc) do { acc2 = f32x16{}; acc3 = f32x16{};                                                                     \
            _Pragma("unroll") for (int s = 0; s < 4; ++s) {                                                                    \
                acc2 = __builtin_amdgcn_mfma_f32_32x32x16_bf16(IDX_AF(2, s), bc[s], acc2, 0, 0, 0);                           \
                acc3 = __builtin_amdgcn_mfma_f32_32x32x16_bf16(IDX_AF(3, s), bc[s], acc3, 0, 0, 0); }                         \
            __builtin_amdgcn_sched_barrier(0); } while (0)
#define IDX_EPI(ACC, LIN, rt, kt_) do {                                                                                     \
                const int myq = 2 * (rt) + hi, key = (kt_) * 32 + r32;                                                        \
                const f32x4* wp = (const f32x4*)(wvl + myq * 16);                                                             \
                float sc = (LIN);                                                                                             \
                _Pragma("unroll") for (int i = 0; i < 4; ++i) { const f32x4 w4 = wp[i];                                       \
                    _Pragma("unroll") for (int jx = 0; jx < 4; ++jx) sc = fmaf(w4[jx], fabsf(ACC[4 * i + jx]), sc); }         \
                const unsigned bits = __float_as_uint(sc);                                                                    \
                unsigned kk = bits ^ ((unsigned)((int)bits >> 31) | 0x80000000u);                                             \
                if (key > t0 + myq) kk = 0u;                                                                                  \
                keys[myq * 4096 + key] = kk; } while (0)
#define IDX_E1(kt_) do { lin2 = acc5[2] + acc5[6]; lin3 = acc5[3] + acc5[7];                                                  \
            IDX_EPI(acc0, acc5[0] + acc5[4], 0, kt_); IDX_EPI(acc1, acc5[1] + acc5[5], 1, kt_); __builtin_amdgcn_sched_barrier(0); } while (0)
#define IDX_E2(kt_) do { IDX_EPI(acc2, lin2, 2, kt_); IDX_EPI(acc3, lin3, 3, kt_); __builtin_amdgcn_sched_barrier(0); } while (0)
#define IDX_STEP(bx, by) { IDX_M2(bx); IDX_LOADB(bx, kt + 24); __builtin_amdgcn_sched_barrier(0); IDX_E1(kt);                  \
            const bool more_ = kt + 8 < ntile; if (more_) IDX_M1(by); IDX_E2(kt); kt += 8; if (!more_) break; }
        {
            f32x16 acc0, acc1, acc2, acc3, acc5; float lin2, lin3;
            int kt = wid;
            if (kt < ntile) {
                IDX_M1(R.b0);
                for (;;) { IDX_STEP(R.b0, R.b1) IDX_STEP(R.b1, R.b2) IDX_STEP(R.b2, R.b0) }
            }
        }
#undef IDX_STEP
#undef IDX_E2
#undef IDX_E1
#undef IDX_EPI
#undef IDX_M2
#undef IDX_M1
#undef IDX_AF
#undef IDX_LOADB
    }
    __syncthreads();
    if (un >= 0) idx_issue(p, un, R);
#pragma unroll 1
    for (int rep = 0; rep < 1 + (PROBE_REP == 9); ++rep)
    {
        const int tq = t0 + wid, n = tq + 1;
        u64 myword = 0;
        if (n <= 256) {
            const int lo = lane * 64;
            myword = (tq >= lo + 63) ? ~0ull : (tq < lo ? 0ull : ((1ull << (tq - lo + 1)) - 1ull));
        } else {
            const int ni = (n + 63) >> 6;
            unsigned kv[64];
#pragma unroll
            for (int i = 0; i < 64; ++i) { const unsigned vv = keys[wid * 4096 + i * 64 + lane]; kv[i] = (i < ni) ? vv : 0u; }
            unsigned kmax = 0;
#pragma unroll
            for (int i = 0; i < 64; ++i) kmax = kv[i] > kmax ? kv[i] : kmax;
#pragma unroll
            for (int o = 32; o > 0; o >>= 1) { const unsigned ot = (unsigned)__shfl_xor((int)kmax, o); kmax = ot > kmax ? ot : kmax; }
            kmax = (unsigned)__builtin_amdgcn_readfirstlane((int)kmax);
            unsigned lo = 1u, hi = kmax + 1u; int c_lo = n, c_hi = 0; bool exact = false;
            { unsigned cand = kmax & 0xFF800000u;
#pragma unroll 1
              for (int st = 0; st < 4 && cand >= 0x00800000u; ++st) {
                  const int c = idx_count(kv, ni, cand);
                  if (c >= 256) { lo = cand; c_lo = c; exact = (c == 256); break; }
                  hi = cand; c_hi = c; cand -= 0x00800000u;
              } }
            if (!exact) {
#pragma unroll 1
                while (hi - lo > 1u && c_lo - c_hi > 64) {
                    const unsigned mid = lo + ((hi - lo) >> 1);
                    const int c = idx_count(kv, ni, mid);
                    if (c == 256) { lo = mid; exact = true; break; }
                    if (c > 256) { lo = mid; c_lo = c; } else { hi = mid; c_hi = c; }
                }
            }
            if (!exact && hi - lo > 1u) {
                unsigned* slot = (unsigned*)(wl + wid * 64);
                int base = 0; const unsigned span = hi - lo;
#pragma unroll
                for (int i = 0; i < 64; ++i) {
                    const bool inb = (kv[i] - lo) < span;
                    const u64 bb = __ballot(inb);
                    if (bb != 0ull) {
                        const int off = base + (int)__builtin_amdgcn_mbcnt_hi((unsigned)(bb >> 32), __builtin_amdgcn_mbcnt_lo((unsigned)bb, 0u));
                        if (inb) slot[off] = kv[i];
                        base += __popcll(bb);
                    }
                }
                const unsigned mine = (lane < base) ? slot[lane] : 0u;
                const int c_above = c_hi;
#pragma unroll 1
                while (hi - lo > 1u) {
                    const unsigned mid = lo + ((hi - lo) >> 1);
                    const int c = c_above + __popcll(__ballot(mine >= mid));
                    if (c == 256) { lo = mid; exact = true; break; }
                    if (c > 256) { lo = mid; c_lo = c; } else { hi = mid; c_hi = c; }
                }
            }
            const unsigned prefix = lo;
            unsigned Tt; int need;
            if (exact) { Tt = prefix - 1u; need = 0; }
            else { Tt = prefix; need = 256 - c_hi; }
            if (need == 0) {
                unsigned mlo = 0u, mhi = 0u; const unsigned Ts = (unsigned)__builtin_amdgcn_readfirstlane((int)Tt);
#define EMIT8(G) idx_emit8<G * 8>(mlo, mhi, Ts, kv[G * 8], kv[G * 8 + 1], kv[G * 8 + 2], kv[G * 8 + 3], kv[G * 8 + 4], kv[G * 8 + 5], kv[G * 8 + 6], kv[G * 8 + 7])
                EMIT8(0); EMIT8(1); EMIT8(2); EMIT8(3); EMIT8(4); EMIT8(5); EMIT8(6); EMIT8(7);
#undef EMIT8
                myword = ((u64)mhi << 32) | mlo;
            } else {
#pragma unroll
                for (int i = 0; i < 64; ++i) {
                    u64 m = __ballot(kv[i] > Tt);
                    if (need > 0) {
                        u64 me = __ballot(kv[i] == Tt);
                        const int pc = __popcll(me), take = pc < need ? pc : need;
                        while (__popcll(me) > take) me &= ~(1ull << (63 - __clzll(me)));
                        need -= take; m |= me;
                    }
                    if (lane == i) myword = m;
                }
            }
        }
        wl[wid * 64 + lane] = myword;
    }
    __syncthreads();
    { const int jj = tid >> 3, qq = tid & 7; p.bm[((size_t)b * 64 + jj) * S + t0 + qq] = wl[qq * 64 + jj]; }
    __syncthreads();
}

constexpr int RL_XIN = 0, RL_XCU = 46592, RL_XA = 91648, RL_SAGG = 116224, RL_CAR = 119040, RL_HALO = 120448, RL_CONST = 121600, RL_WG = 124544, RL_WSTR = 104;
DEVI void rnn_quarter(const Params& p, int l, int sq, unsigned char* smem, bool dry) {
    const int tid = otid(), wid = __builtin_amdgcn_readfirstlane(tid >> 6), lane = tid & 63;
    const int n = sq & 15, q = (sq >> 4) & 3, b = sq >> 6;
    float* xin = (float*)(smem + RL_XIN);
    float* xcu = (float*)(smem + RL_XCU);
    bf16_t* xa = (bf16_t*)(smem + RL_XA);
    f32x2* sagg = (f32x2*)(smem + RL_SAGG);
    f32x2* car = (f32x2*)(smem + RL_CAR);
    float* halo = (float*)(smem + RL_HALO);
    float* cst = (float*)(smem + RL_CONST);
    bf16_t* wg = (bf16_t*)(smem + RL_WG);
    const int fr = lane & 15, fq = lane >> 4;
    const int sc_ = tid % 88, sg = tid / 88;
    {
        const bf16_t* Wg = (l ? p.Wsm1 : p.Wsm0) + OFF_WG;
        for (int c = tid; c < 2 * 88 * 12; c += 512) { const int gsel = c / (88 * 12), r = (c / 12) % 88, k8 = c % 12;
            *(u32x4*)(wg + (gsel * 88 + r) * RL_WSTR + k8 * 8) = *(const u32x4*)(Wg + (((size_t)gsel * 16 + n) * 96 + r) * 96 + k8 * 8); }
        if (tid < 96) { const int gc = l * DR + n * 88 + tid; const bool ok = tid < 88;
            cst[tid] = ok ? p.b_rg[gc] : 0.f; cst[96 + tid] = ok ? p.b_ig[gc] : 0.f; cst[192 + tid] = ok ? log1pf(__expf(-p.lam[gc])) : 0.f; }
        if (tid >= 128 && tid < 128 + 88) { const int c = tid - 128; const float* cw = p.conv_w + (size_t)l * 4 * DR + n * 88 + c;
            cst[288 + c] = cw[0]; cst[288 + 88 + c] = cw[DR]; cst[288 + 176 + c] = cw[2 * DR]; cst[288 + 264 + c] = cw[3 * DR]; cst[288 + 352 + c] = p.conv_b[(size_t)l * DR + n * 88 + c]; }
        if (tid >= 256 && tid < 256 + 88) car[tid - 256] = (f32x2){1.f, 0.f};
        if (tid >= 384 && tid < 384 + 33) { const int c = tid - 384, r = c / 11, cc = c - r * 11;
            f32x4 a0 = {0.f, 0.f, 0.f, 0.f}, a1 = a0;
            if (q > 0) load8f(p.halo + ((size_t)(b * 4 + q - 1) * 3 + r) * DR + n * 88 + cc * 8, a0, a1);
            *(f32x4*)(halo + r * 88 + cc * 8) = a0; *(f32x4*)(halo + r * 88 + cc * 8 + 4) = a1; }
    }
    __syncthreads();
    const float cw0 = cst[288 + sc_], cw1 = cst[288 + 88 + sc_], cw2 = cst[288 + 176 + sc_], cw3 = cst[288 + 264 + sc_], cbv = cst[288 + 352 + sc_];
    u32x4 xw[3], gw[3], xwn[3];
#define RNN_LOADX(dst, tk) do { _Pragma("unroll") for (int i = 0; i < 3; ++i) { const int c = tid + 512 * i, r = c / 11, cc = c - r * 11; \
            dst[i] = (u32x4){0u, 0u, 0u, 0u}; if (c < 128 * 11) dst[i] = *(const u32x4*)(p.xr + ((tk) + r) * DR + n * 88 + cc * 8); } } while (0)
    RNN_LOADX(xw, (size_t)b * S + q * 1024);
#pragma unroll 1
    for (int jc = 0; jc < 8; ++jc) {
        const int t0 = q * 1024 + jc * 128; const size_t tok0 = (size_t)b * S + t0;
#pragma unroll
        for (int i = 0; i < 3; ++i) { const int c = tid + 512 * i, r = c / 11, cc = c - r * 11;
            gw[i] = (u32x4){0u, 0u, 0u, 0u};
            if (c < 128 * 11) gw[i] = *(const u32x4*)(p.sgr + (tok0 + r) * DR + n * 88 + cc * 8); }
        if (tid < 264) xin[tid] = halo[tid];
#pragma unroll
        for (int i = 0; i < 3; ++i) { const int c = tid + 512 * i;
            if (c < 128 * 11) { const u32x4 w = xw[i]; float* d = xin + 264 + c * 8;
                *(f32x4*)d = (f32x4){bf_lo(w.x), bf_hi(w.x), bf_lo(w.y), bf_hi(w.y)}; *(f32x4*)(d + 4) = (f32x4){bf_lo(w.z), bf_hi(w.z), bf_lo(w.w), bf_hi(w.w)}; } }
        __syncthreads();
        if (jc < 7) RNN_LOADX(xwn, tok0 + 128);
        if (tid < 264) halo[tid] = xin[128 * 88 + tid];
        if (tid < 440) {
            const int tb0 = sg * 26;
            float x0 = xin[tb0 * 88 + sc_], x1 = xin[(tb0 + 1) * 88 + sc_], x2 = xin[(tb0 + 2) * 88 + sc_];
#pragma unroll
            for (int tt = 0; tt < 26; tt += 13) {
                float xn[13];
#pragma unroll
                for (int e = 0; e < 13; ++e) { const int t = tb0 + tt + e; xn[e] = (t < 128) ? xin[(t + 3) * 88 + sc_] : 0.f; }
#pragma unroll
                for (int e = 0; e < 13; ++e) { const int t = tb0 + tt + e;
                    const float vv = cbv + cw0 * x0 + cw1 * x1 + cw2 * x2 + cw3 * xn[e];
                    if (t < 128) { xcu[t * 88 + sc_] = vv; xa[t * 96 + sc_] = f2bf(vv); }
                    x0 = x1; x1 = x2; x2 = xn[e]; }
            }
        } else { for (int e = tid - 440; e < 128 * 8; e += 72) xa[(e >> 3) * 96 + 88 + (e & 7)] = 0; }
        __syncthreads();
        f32x2* wagg = (f32x2*)(smem + RL_XA);
        f32x2* wcar = wagg + 8 * 88;
        float* aout = xin;
        {
            bf16x8 a[3];
#pragma unroll
            for (int s3 = 0; s3 < 3; ++s3) a[s3] = *(const bf16x8*)(xa + (wid * 16 + fr) * 96 + s3 * 32 + fq * 8);
            __syncthreads();
#pragma unroll
            for (int nt = 0; nt < 6; ++nt) {
                f32x4 accr = {0.f, 0.f, 0.f, 0.f}, acci = accr;
                const bf16_t* wr_ = wg + (nt * 16 + fr) * RL_WSTR + fq * 8; const bf16_t* wi_ = wr_ + 88 * RL_WSTR;
#pragma unroll
                for (int s3 = 0; s3 < 3; ++s3) {
                    accr = __builtin_amdgcn_mfma_f32_16x16x32_bf16(a[s3], *(const bf16x8*)(wr_ + s3 * 32), accr, 0, 0, 0);
                    acci = __builtin_amdgcn_mfma_f32_16x16x32_bf16(a[s3], *(const bf16x8*)(wi_ + s3 * 32), acci, 0, 0, 0);
                }
                const int c = nt * 16 + fr; const bool okc = c < 88; const int cs = okc ? c : 87;
                const float brg = cst[cs], big = cst[96 + cs], sp = cst[192 + cs];
                float Pl[4], hl[4];
                { float P = 1.f, h = 0.f;
#pragma unroll
                  for (int r = 0; r < 4; ++r) {
                      const int t = wid * 16 + fq * 4 + r;
                      const float rg = sigmoidf_(accr[r] + brg), ig = sigmoidf_(acci[r] + big);
                      const float la = -8.0f * rg * sp, av = __expf(la), mult = __builtin_amdgcn_sqrtf(-expm1_small(2.0f * la));
                      const float uv = mult * ig * xcu[t * 88 + cs];
                      h = av * h + uv; P *= av; Pl[r] = P; hl[r] = h; } }
                float Pg = Pl[3], hg = hl[3];
                { const float Pp = __shfl_up(Pg, 16), hp = __shfl_up(hg, 16); if (fq >= 1) { hg = Pg * hp + hg; Pg = Pp * Pg; } }
                { const float Pp = __shfl_up(Pg, 32), hp = __shfl_up(hg, 32); if (fq >= 2) { hg = Pg * hp + hg; Pg = Pp * Pg; } }
                float Pe = __shfl_up(Pg, 16), he = __shfl_up(hg, 16); if (fq == 0) { Pe = 1.f; he = 0.f; }
                if (okc) {
#pragma unroll
                    for (int r = 0; r < 4; ++r) { const int t = wid * 16 + fq * 4 + r; aout[t * 88 + c] = Pe * Pl[r]; xcu[t * 88 + c] = Pl[r] * he + hl[r]; }
                    if (fq == 3) wagg[wid * 88 + c] = (f32x2){Pg, hg};
                }
            }
        }
        __syncthreads();
        if (tid < 88) {
            f32x2 cr = car[(jc & 1) * 88 + tid]; float P = cr[0], h = cr[1];
#pragma unroll
            for (int w8 = 0; w8 < 8; ++w8) { wcar[w8 * 88 + tid] = (f32x2){P, h}; const f32x2 gq = wagg[w8 * 88 + tid]; h = gq[0] * h + gq[1]; P *= gq[0]; }
            car[((jc + 1) & 1) * 88 + tid] = (f32x2){P, h};
        }
        __syncthreads();
#pragma unroll
        for (int i = 0; i < 3; ++i) { const int c = tid + 512 * i, r = c / 11, cc = c - r * 11;
            if (c < 128 * 11) {
                const u32x4 w = gw[i];
                const f32x4 g0 = {bf_lo(w.x), bf_hi(w.x), bf_lo(w.y), bf_hi(w.y)}, g1 = {bf_lo(w.z), bf_hi(w.z), bf_lo(w.w), bf_hi(w.w)};
                const float* hp = xcu + c * 8; const float* pp = aout + c * 8;
                const f32x2* wcp = wcar + (r >> 4) * 88 + cc * 8;
                f32x4 cP0, cP1, cH0, cH1;
#pragma unroll
                for (int e = 0; e < 4; ++e) { const f32x2 w0 = wcp[e], w1 = wcp[4 + e]; cP0[e] = w0[0]; cH0[e] = w0[1]; cP1[e] = w1[0]; cH1[e] = w1[1]; }
                const f32x4 pl0 = *(const f32x4*)pp, pl1 = *(const f32x4*)(pp + 4);
                const f32x4 hh0 = *(const f32x4*)hp + pl0 * cH0, hh1 = *(const f32x4*)(hp + 4) + pl1 * cH1;
                if (!dry) store8(p.sgr + (tok0 + r) * DR + n * 88 + cc * 8, g0 * hh0, g1 * hh1);
                if (q > 0 && !dry) store8(p.xr + (tok0 + r) * DR + n * 88 + cc * 8, g0 * (pl0 * cP0), g1 * (pl1 * cP1));
            } }
#pragma unroll
        for (int i = 0; i < 3; ++i) xw[i] = xwn[i];
        __syncthreads();
    }
#undef RNN_LOADX
    if (tid < 88) *(f32x2*)(p.agg + (((size_t)b * 4 + q) * DR + n * 88 + tid) * 2) = car[tid];
    __syncthreads();
}
DEVI void rnn_fix(const Params& p, int task, unsigned char* smem) {
    const int tid = otid();
    const int sidx = task >> 2, sub = task & 3;
    const int b = sidx / 48, rem = sidx - b * 48, q = 1 + rem / 16, n = rem & 15;
    float* Cq = (float*)smem;
    if (tid < 88) { float h = 0.f;
        for (int qq = 0; qq < q; ++qq) { const f32x2 gq = *(const f32x2*)(p.agg + (((size_t)b * 4 + qq) * DR + n * 88 + tid) * 2); h = gq[0] * h + gq[1]; }
        Cq[tid] = h; }
    __syncthreads();
    const size_t tok0 = (size_t)b * S + q * 1024 + sub * 256;
    u32x4 hv[6], sv[6];
#pragma unroll
    for (int i = 0; i < 6; ++i) { const int c = tid + 512 * i, r = c / 11, cc = c - r * 11;
        if (c < 256 * 11) { hv[i] = *(const u32x4*)(p.sgr + (tok0 + r) * DR + n * 88 + cc * 8); sv[i] = *(const u32x4*)(p.xr + (tok0 + r) * DR + n * 88 + cc * 8); } }
#pragma unroll
    for (int i = 0; i < 6; ++i) { const int c = tid + 512 * i, r = c / 11, cc = c - r * 11;
        if (c < 256 * 11) {
            const u32x4 hw = hv[i], sw = sv[i];
            const f32x4 h0 = {bf_lo(hw.x), bf_hi(hw.x), bf_lo(hw.y), bf_hi(hw.y)}, h1 = {bf_lo(hw.z), bf_hi(hw.z), bf_lo(hw.w), bf_hi(hw.w)};
            const f32x4 s0 = {bf_lo(sw.x), bf_hi(sw.x), bf_lo(sw.y), bf_hi(sw.y)}, s1 = {bf_lo(sw.z), bf_hi(sw.z), bf_lo(sw.w), bf_hi(sw.w)};
            const f32x4 c0 = *(const f32x4*)(Cq + cc * 8), c1 = *(const f32x4*)(Cq + cc * 8 + 4);
            store8(p.sgr + (tok0 + r) * DR + n * 88 + cc * 8, h0 + s0 * c0, h1 + s1 * c1); } }
    __syncthreads();
}

DEVI void phase_prep_rows(const Params& p) {
    const int tid_ = otid(), wid = tid_ >> 6, lane = tid_ & 63;
    const int step = gridDim.x * 8;
    for (int row0 = blockIdx.x * 8 + wid; row0 < T; row0 += 4 * step) {
        f32x4 vq[4][4];
#pragma unroll
        for (int k = 0; k < 4; ++k) { const int rk = (row0 + k * step < T) ? row0 + k * step : row0; const f32x4* xp = (const f32x4*)(p.x + (size_t)rk * 1024);
#pragma unroll
            for (int i = 0; i < 4; ++i) vq[k][i] = xp[i * 64 + lane]; }
#pragma unroll
        for (int k = 0; k < 4; ++k) { const int row = row0 + k * step;
            if (row < T) { float s = 0.f;
#pragma unroll
                for (int i = 0; i < 4; ++i) { const f32x4 vv = vq[k][i]; s += (vv[0] * vv[0] + vv[1] * vv[1]) + (vv[2] * vv[2] + vv[3] * vv[3]);
                    u32x2 w; w.x = cvtpk(vv[0], vv[1]); w.y = cvtpk(vv[2], vv[3]); *(u32x2*)(p.xb + (size_t)row * 1024 + (i * 64 + lane) * 4) = w; }
                s = wave_sum(s);
                if (lane < 16) p.ssq[(size_t)row * 16 + lane] = (lane == 0) ? s : 0.f; } }
    }
}
DEVI int win_src_col(int np) {
    const int pn = np >> 8, pp = np & 255, bj = pp >> 7, o = pp & 127;
    if (pn < 8) { const int hsel = o >> 6, i = o & 63; return (pn >= 4 ? 1024 : 0) + (2 * (pn & 3) + hsel) * 128 + bj * 64 + i; }
    if (pn < 12) return 2048 + (pn - 8) * 256 + pp;
    if (pn < 16) { const int hsel = o >> 5, i = o & 31; return 4096 + (4 * (pn - 12) + hsel) * 64 + bj * 32 + i; }
    if (pn < 27) return 5200 + (pn - 16) * 256 + pp;
    if (pn == 27) { if (bj == 0) { if (o < 32) return 5120 + o; if (o < 48) return 5184 + (o - 32); return -1; } else { if (o < 32) return 5152 + o; return -1; } }
    if (pn < 32) return 3072 + (pn - 28) * 256 + pp;
    if (pn < 36) return 8016 + (pn - 32) * 256 + pp;
    return 9040 + (pn - 36) * 256 + pp;
}
template <bool SCALE, bool WINMAP>
DEVI void conv_tile(const float* src, int ldsrc, int K, const float* scale, bf16_t* dst, int n0, int k0, unsigned char* smem) {
    float* tile = (float*)smem;
    const int tid = otid(), w = tid >> 6, lane = tid & 63;
    const int sc = WINMAP ? win_src_col(n0 + lane) : (n0 + lane);
    const int scs = sc < 0 ? 0 : sc; const float msk = sc < 0 ? 0.f : 1.f;
    float vv[8], gg[8];
#pragma unroll
    for (int r = 0; r < 8; ++r) { vv[r] = src[(size_t)(k0 + w * 8 + r) * ldsrc + scs]; gg[r] = SCALE ? scale[k0 + w * 8 + r] : 1.f; }
#pragma unroll
    for (int r = 0; r < 8; ++r) tile[(w * 8 + r) * 65 + lane] = vv[r] * gg[r] * msk;
    __syncthreads();
    { const int nn = tid >> 3, k8 = (tid & 7) * 8; f32x4 a0, a1;
#pragma unroll
      for (int e = 0; e < 4; ++e) { a0[e] = tile[(k8 + e) * 65 + nn]; a1[e] = tile[(k8 + 4 + e) * 65 + nn]; }
      store8(dst + (size_t)(n0 + nn) * K + k0 + k8, a0, a1); }
    __syncthreads();
}
struct ConvD { const float* src; const float* scale; bf16_t* dst; int ldsrc, K, n0, k0; bool scaled, winmap; };
DEVI void conv_tiles4(const ConvD (&d)[4], int cnt, unsigned char* smem) {
    const int tid = otid(), w = tid >> 6, lane = tid & 63;
    float vv[4][8];
#pragma unroll
    for (int j = 0; j < 4; ++j) {
        const int sc = d[j].winmap ? win_src_col(d[j].n0 + lane) : (d[j].n0 + lane);
        const int scs = sc < 0 ? 0 : sc; const float msk = sc < 0 ? 0.f : 1.f;
#pragma unroll
        for (int r = 0; r < 8; ++r) { const int kk = d[j].k0 + w * 8 + r;
            const float gq = d[j].scale[kk];
            vv[j][r] = d[j].src[(size_t)kk * d[j].ldsrc + scs] * (d[j].scaled ? gq * msk : msk); }
    }
#pragma unroll
    for (int j = 0; j < 4; ++j) { float* tile = (float*)(smem + j * 16640);
#pragma unroll
        for (int r = 0; r < 8; ++r) tile[(w * 8 + r) * 65 + lane] = vv[j][r]; }
    __syncthreads();
    { const int nn = tid >> 3, k8 = (tid & 7) * 8;
#pragma unroll
      for (int j = 0; j < 4; ++j) { if (j < cnt) { const float* tile = (const float*)(smem + j * 16640); f32x4 a0, a1;
#pragma unroll
          for (int e = 0; e < 4; ++e) { a0[e] = tile[(k8 + e) * 65 + nn]; a1[e] = tile[(k8 + 4 + e) * 65 + nn]; }
          store8(d[j].dst + (size_t)(d[j].n0 + nn) * d[j].K + d[j].k0 + k8, a0, a1); } } }
    __syncthreads();
}
DEVI void convert_big(const Params& p, int l, unsigned char* smem, int first, int stride) {
    const float* src = p.w_in + (size_t)l * 1024 * NIN; const float* g = p.norm_g + (size_t)l * 1024;
    for (int i = first; i < 160 * 16; i += 4 * stride) {
        ConvD d[4]; int cnt = 0;
#pragma unroll
        for (int j = 0; j < 4; ++j) { const int ii = i + j * stride; const bool ok = ii < 160 * 16; if (ok) cnt = j + 1; const int iu = ok ? ii : i;
            d[j] = ConvD{src, g, p.WinT, NIN, 1024, (iu >> 4) * 64, (iu & 15) * 64, true, true}; }
        conv_tiles4(d, cnt, smem);
    }
}
DEVI void convert_small(const Params& p, int l, unsigned char* smem, int first, int stride) {
    bf16_t* W = l ? p.Wsm1 : p.Wsm0;
    for (int i = first; i < 256; i += stride) {
        const int i2 = i + 256 < 352 ? i + 256 : i;
        ConvD d[4];
        d[0] = ConvD{p.w_oa + (size_t)l * 1024 * 1024, p.norm_g, W + OFF_WA, 1024, 1024, (i >> 4) * 64, (i & 15) * 64, false, false};
        d[1] = ConvD{p.w_o + (size_t)l * 1024 * 1024, p.norm_g, W + OFF_WO, 1024, 1024, (i >> 4) * 64, (i & 15) * 64, false, false};
        d[2] = ConvD{p.w_or + (size_t)l * DR * 1024, p.norm_g, W + OFF_WB, 1024, DR, (i / 22) * 64, (i % 22) * 64, false, false};
        d[3] = ConvD{p.w_or + (size_t)l * DR * 1024, p.norm_g, W + OFF_WB, 1024, DR, (i2 / 22) * 64, (i2 % 22) * 64, false, false};
        conv_tiles4(d, i + 256 < 352 ? 4 : 3, smem);
    }
    for (int e = first * 512 + otid(); e < 2 * 16 * 96 * 96; e += stride * 512) {
        const int k = e % 96, nn = (e / 96) % 96, blk = (e / 9216) % 16, gsel = e / (9216 * 16);
        float vv = 0.f;
        if (k < 88 && nn < 88) vv = (gsel ? p.w_ig : p.w_rg)[(((size_t)l * 16 + blk) * 88 + k) * 88 + nn];
        W[OFF_WG + e] = f2bf(vv);
    }
}
DEVI void phase_final(const Params& p) {
    const int tid_ = otid(), wid = tid_ >> 6, lane = tid_ & 63;
    for (int row = blockIdx.x * 8 + wid; row < T; row += gridDim.x * 8) {
        const float rs = row_rstd(p.ssq, row);
        f32x4* xp = (f32x4*)(p.out + (size_t)row * 1024); const f32x4* gp = (const f32x4*)p.fin_g;
#pragma unroll
        for (int i = 0; i < 4; ++i) { const f32x4 vv = xp[i * 64 + lane], gg = gp[i * 64 + lane]; xp[i * 64 + lane] = vv * rs * gg; }
    }
}


#define XB_TMO      128
#define XB_XCNT(j)  (256  + 64 * (j))
#define XB_XSUB(j)  (1280 + 64 * (j))
#define XB_XGEN(j)  (2304 + 64 * (j))
#define XB_TOP      3328
#define XB_TOPGEN   3392
#define XCD_BAR_WORDS 3456
#define XB_SPIN_CAP (1u << 18)
DEVI unsigned xb_ld(unsigned* p)              { return __hip_atomic_load(p, __ATOMIC_RELAXED, __HIP_MEMORY_SCOPE_AGENT); }
DEVI unsigned xb_add(unsigned* p, unsigned v) { return __hip_atomic_fetch_add(p, v, __ATOMIC_RELAXED, __HIP_MEMORY_SCOPE_AGENT); }
DEVI unsigned xb_xcc_id() { return (unsigned)__builtin_amdgcn_s_getreg((3 << 11) | 20) & 0xFu; }
#define XB_SPIN(cond, bar) do { unsigned _sp = 0; while (cond) { __builtin_amdgcn_s_sleep(1); \
    if ((++_sp & 255u) == 0u) { if (xb_ld(&(bar)[XB_TMO])) break; if (_sp > XB_SPIN_CAP) { atomicAdd(&(bar)[XB_TMO], 1u); break; } } } } while (0)
struct XcdBarrier { unsigned* bar; unsigned x; volatile LAS unsigned* st; };
DEVI XcdBarrier xcd_barrier_post(unsigned* bar, volatile LAS unsigned* st) {
    XcdBarrier b; b.bar = bar; b.x = xb_xcc_id(); b.st = st;
    if (threadIdx.x == 0) (void)xb_add(&bar[XB_XCNT(b.x)], 1u);
    return b;
}
DEVI void xcd_barrier_complete(unsigned* bar, unsigned x, unsigned& nloc, unsigned& nx) {
    const unsigned G = gridDim.x * gridDim.y * gridDim.z;
    unsigned sum, cnt, mine, sp = 0u;
    for (;;) {
        sum = 0u; cnt = 0u; mine = 0u;
#pragma unroll
        for (unsigned j = 0; j < 16; ++j) { const unsigned c = xb_ld(&bar[XB_XCNT(j)]); sum += c; cnt += (c > 0u) ? 1u : 0u; mine = (j == x) ? c : mine; }
        if (sum == G) break;
        __builtin_amdgcn_s_sleep(1);
        if ((++sp & 255u) == 0u) { if (xb_ld(&bar[XB_TMO])) break; if (sp > XB_SPIN_CAP) { atomicAdd(&bar[XB_TMO], 1u); break; } }
    }
    nloc = mine > 0u ? mine : 1u; nx = cnt > 0u ? cnt : 1u;
}
DEVI void xcd_barrier(const XcdBarrier& b) {
    asm volatile("s_waitcnt vmcnt(0)" ::: "memory");
    __syncthreads();
    if (threadIdx.x == 0) {
        unsigned* bar = b.bar;
        __builtin_amdgcn_s_waitcnt(0);
        unsigned nloc = b.st[0], nx = b.st[1];
        if (nloc == 0u) { xcd_barrier_complete(bar, b.x, nloc, nx); b.st[0] = nloc; b.st[1] = nx; }
        const unsigned old = xb_add(&bar[XB_XSUB(b.x)], 1u);
        const unsigned gen = old / nloc;
        if (old + 1u == (gen + 1u) * nloc) {
            __builtin_amdgcn_fence(__ATOMIC_RELEASE, "agent");
            asm volatile("s_waitcnt vmcnt(0)" ::: "memory");
            const unsigned og = xb_add(&bar[XB_TOP], 1u);
            const unsigned tg = og / nx;
            if (og + 1u == (tg + 1u) * nx) xb_add(&bar[XB_TOPGEN], 1u);
            else XB_SPIN(xb_ld(&bar[XB_TOPGEN]) == tg, bar);
            __builtin_amdgcn_fence(__ATOMIC_ACQUIRE, "agent");
            xb_add(&bar[XB_XGEN(b.x)], 1u);
            asm volatile("s_waitcnt vmcnt(0)" ::: "memory");
        } else {
            XB_SPIN(xb_ld(&bar[XB_XGEN(b.x)]) == gen, bar);
            __builtin_amdgcn_fence(__ATOMIC_ACQUIRE, "agent");
            asm volatile("s_waitcnt vmcnt(0)" ::: "memory");
        }
    }
    __syncthreads();
}

DEVI void run_phase(const Params& p, int ph, unsigned char* smem) {
    LAS unsigned char* lds = (LAS unsigned char*)smem;
    const int G = gridDim.x, c = blockIdx.x;
    if (ph == 0) {
        phase_prep_rows(p);
        for (int rep = 0; rep < 1 + (PROBE_REP == 5); ++rep)
        convert_big(p, 0, smem, c, G);
        convert_small(p, 0, smem, c, G);
        return;
    }
    if (ph == NPH - 1) { phase_final(p); return; }
    const int l = (ph - 1) / 6, kind = (ph - 1) % 6;
    const bf16_t* Wsm = l ? p.Wsm1 : p.Wsm0;
    bf16_t* sma = p.iq; bf16_t* smb = p.xr; bf16_t* yag = p.k; bf16_t* merged = p.v; bf16_t* ag = p.q; bf16_t* hg = p.sgr;
    pg8::StaticOrder so;
    if (kind == 0) {
        pg8::Gemm g{p.xb, p.WinT, T, 28 * 256, 1024}; so.init(g.M, g.N, G, c);
        fill_rstd(p.ssq, p.pos, so, smem);
        EpiPA1 e{(const float*)(smem + RS_OFF), p.pos, p.q, p.k, p.v, p.iq, p.ik, p.xr, p.sgr, p.iw, p.halo};
        if (PROBE_REP == 11) { EpiTriv et{p.v}; pg8::gemm_phase(lds, g, so, et); }
        for (int rep = 0; rep < 1 + (PROBE_REP == 3); ++rep)
        pg8::gemm_phase(lds, g, so, e);
    } else if (kind == 1) {
#ifndef SKIP_IDX
        { IdxPre R; idx_issue(p, c, R);
          for (int u = c; u < 2048; u += G) idx_unit(p, u, (u + G < 2048) ? u + G : -1, R, smem); }
#endif
        if (PROBE_REP == 2) { for (int sq = c; sq < 256; sq += G) rnn_quarter(p, l, sq, smem, true); }
        for (int sq = c; sq < 256; sq += G) rnn_quarter(p, l, sq, smem, false);
    } else if (kind == 2) {
#ifndef SKIP_ATT
        if (PROBE_REP == 4) phase_attention(p, smem, p.iq);
        phase_attention(p, smem, p.q);
#endif
        for (int tk = c; tk < 768; tk += G) rnn_fix(p, tk, smem);
        if (l == 0) convert_small(p, 1, smem, c, G);
    } else if (kind == 3) {
        pg8::Gemm g{p.xb, p.WinT + (size_t)28 * 256 * 1024, T, 12 * 256, 1024}; so.init(g.M, g.N, G, c);
        fill_rstd(p.ssq, p.pos, so, smem);
        EpiPA2 e{(const float*)(smem + RS_OFF), ag, sma, smb};
        pg8::gemm_phase(lds, g, so, e);
    } else if (kind == 4) {
        for (int rep = 0; rep < 1 + (PROBE_REP == 6); ++rep) {
        { pg8::Gemm g{ag, Wsm + OFF_WA, T, 1024, 1024}; so.init(g.M, g.N, G, c);
          EpiPD<0> e{sma, nullptr, yag}; pg8::gemm_phase(lds, g, so, e); }
        { pg8::Gemm g{hg, Wsm + OFF_WB, T, 1024, DR}; so.init(g.M, g.N, G, c);
          EpiPD<1> e{smb, yag, merged}; pg8::gemm_phase(lds, g, so, e); }
        }
        if (l == 0) convert_big(p, 1, smem, c, G);
    } else {
        pg8::Gemm g{merged, Wsm + OFF_WO, T, 1024, 1024}; so.init(g.M, g.N, G, c);
        EpiPE e{l == 0 ? p.x : p.out, p.out, p.xb, p.ssq};
        pg8::gemm_phase(lds, g, so, e);
    }
}

__global__ void __launch_bounds__(512, 2) hybrid_fwd(Params p, int ph_lo, int ph_hi) {
    extern __shared__ __attribute__((aligned(16))) unsigned char smem[];
    volatile LAS unsigned* st = (volatile LAS unsigned*)((LAS unsigned char*)smem + (LDS_BYTES - 16));
    if (threadIdx.x == 0) { st[0] = 0u; st[1] = 0u; }
    __syncthreads();
    const XcdBarrier bar = xcd_barrier_post(p.bar, st);
    if (ph_hi < 0) cg::this_grid().sync();
    if (PROBE_REP == 10) { for (int i = 0; i < 20; ++i) xcd_barrier(bar); }
    for (int ph = ph_lo; ph < ph_hi; ++ph) {
        if (ph > ph_lo) xcd_barrier(bar);
        run_phase(p, ph, smem);
    }
}

extern "C" void kernel_launch(void* const* d_in, const int* in_sizes, int n_in, void* d_out, int out_size, void* d_ws, size_t ws_size, hipStream_t stream) {
    static int grid = 0;
    size_t off = 0; auto take = [&](size_t bytes) { size_t o = off; off += (bytes + 255) & ~(size_t)255; return o; };
    const size_t o_WinT = take((size_t)10240 * 1024 * 2), o_W0 = take(WSM_ELEMS * 2), o_W1 = take(WSM_ELEMS * 2);
    const size_t o_xb = take((size_t)T * 1024 * 2), o_ssq = take((size_t)T * 16 * 4);
    const size_t o_q = take((size_t)T * 1024 * 2), o_k = take((size_t)T * 1024 * 2), o_v = take((size_t)T * 1024 * 2), o_iq = take((size_t)T * 1024 * 2);
    const size_t o_ik = take((size_t)T * 64 * 2), o_iw = take((size_t)T * 16 * 4);
    const size_t o_xr = take((size_t)T * DR * 2), o_sgr = take((size_t)T * DR * 2);
    const size_t o_bm = take((size_t)NB * 64 * S * 8), o_agg = take((size_t)NB * 32 * DR * 2 * 4), o_bar = take((size_t)XCD_BAR_WORDS * 4), o_halo = take((size_t)16 * 3 * DR * 2);
    if (grid == 0) {
        if (n_in != 15 || out_size != T * 1024 || ws_size < off) { fprintf(stderr, "kernel_launch: unexpected shapes / workspace (n_in %d out %d ws %zu need %zu)\n", n_in, out_size, ws_size, off); grid = -1; return; }
        int dev = 0, cus = 0, per_cu = 0;
        (void)hipGetDevice(&dev); (void)hipDeviceGetAttribute(&cus, hipDeviceAttributeMultiprocessorCount, dev);
        if (hipFuncSetAttribute((const void*)hybrid_fwd, hipFuncAttributeMaxDynamicSharedMemorySize, LDS_BYTES) != hipSuccess) { fprintf(stderr, "kernel_launch: hipFuncSetAttribute failed\n"); grid = -1; return; }
        if (hipOccupancyMaxActiveBlocksPerMultiprocessor(&per_cu, (const void*)hybrid_fwd, 512, LDS_BYTES) != hipSuccess || per_cu < 1) { fprintf(stderr, "kernel_launch: occupancy query failed (%d)\n", per_cu); per_cu = 1; }
        (void)hipGetLastError();
        grid = cus * 1;
        if (grid <= 0) grid = 256;
    }
    if (grid < 0) return;
    Params p{};
    p.x = (const float*)d_in[0]; p.pos = (const int*)d_in[1]; p.norm_g = (const float*)d_in[2]; p.w_in = (const float*)d_in[3];
    p.conv_w = (const float*)d_in[4]; p.conv_b = (const float*)d_in[5]; p.w_rg = (const float*)d_in[6]; p.b_rg = (const float*)d_in[7];
    p.w_ig = (const float*)d_in[8]; p.b_ig = (const float*)d_in[9]; p.lam = (const float*)d_in[10]; p.w_oa = (const float*)d_in[11];
    p.w_or = (const float*)d_in[12]; p.w_o = (const float*)d_in[13]; p.fin_g = (const float*)d_in[14];
    p.out = (float*)d_out;
    unsigned char* ws = (unsigned char*)d_ws;
    p.WinT = (bf16_t*)(ws + o_WinT); p.Wsm0 = (bf16_t*)(ws + o_W0); p.Wsm1 = (bf16_t*)(ws + o_W1);
    p.xb = (bf16_t*)(ws + o_xb); p.ssq = (float*)(ws + o_ssq); p.q = (bf16_t*)(ws + o_q); p.k = (bf16_t*)(ws + o_k); p.v = (bf16_t*)(ws + o_v);
    p.iq = (bf16_t*)(ws + o_iq); p.ik = (bf16_t*)(ws + o_ik); p.iw = (float*)(ws + o_iw); p.xr = (bf16_t*)(ws + o_xr); p.sgr = (bf16_t*)(ws + o_sgr);
    p.bm = (u64*)(ws + o_bm); p.agg = (float*)(ws + o_agg); p.bar = (unsigned*)(ws + o_bar); p.halo = (bf16_t*)(ws + o_halo);
    (void)hipMemsetAsync(ws + o_bar, 0, (size_t)XCD_BAR_WORDS * 4, stream);
#if N_LAUNCH_MODE == 1
    int lo = 0, hi = NPH; void* args[] = {&p, &lo, &hi};
    hipError_t e = hipLaunchCooperativeKernel((const void*)hybrid_fwd, dim3(grid), dim3(512), args, LDS_BYTES, stream);
    if (e != hipSuccess) fprintf(stderr, "cooperative launch failed: %s (grid %d)\n", hipGetErrorString(e), grid);
#else
    for (int ph = 0; ph < NPH; ++ph) hipLaunchKernelGGL(hybrid_fwd, dim3(grid), dim3(512), LDS_BYTES, stream, p, ph, ph + 1);
#endif
}
```

```cpp
#include <hip/hip_runtime.h>
#include <hip/hip_cooperative_groups.h>
#include <cstdio>
#include <cstdint>
namespace cg = cooperative_groups;

#ifndef N_LAUNCH_MODE
#define N_LAUNCH_MODE 1
#endif

#ifndef PROBE_REP
#define PROBE_REP 0
#endif
#define DEVI __device__ __forceinline__
#define LAS __attribute__((address_space(3)))
typedef unsigned short bf16_t;
typedef short bf16x8 __attribute__((ext_vector_type(8)));
typedef short s16x4 __attribute__((ext_vector_type(4)));
typedef float f32x2 __attribute__((ext_vector_type(2)));
typedef float f32x4 __attribute__((ext_vector_type(4)));
typedef float f32x16 __attribute__((ext_vector_type(16)));
typedef unsigned u32x2 __attribute__((ext_vector_type(2)));
typedef unsigned u32x4 __attribute__((ext_vector_type(4)));
typedef unsigned long long u64;

constexpr int T = 16384, S = 4096, NB = 4, DM = 1024, DR = 1408, NIN = 10064;
constexpr int LDS_BYTES = 160 * 1024;
constexpr int NPH = 14;

__device__ const float c_inv128[64] = {
1.0f,0.865964353f,0.749894202f,0.649381638f,0.562341332f,0.486967534f,0.421696514f,0.365174115f,0.316227764f,0.273841977f,0.237137377f,0.2053525f,0.177827939f,0.153992653f,0.133352146f,0.115478195f,0.100000001f,0.0865964293f,0.0749894232f,0.0649381652f,0.0562341325f,0.0486967526f,0.0421696492f,0.0365174115f,0.0316227749f,0.0273841955f,0.0237137377f,0.0205352511f,0.0177827943f,0.0153992651f,0.013335214f,0.0115478197f,0.00999999978f,0.00865964312f,0.00749894232f,0.00649381615f,0.00562341325f,0.00486967526f,0.00421696482f,0.00365174119f,0.00316227763f,0.00273841969f,0.00237137382f,0.00205352507f,0.00177827943f,0.00153992651f,0.00133352145f,0.00115478202f,0.00100000005f,0.000865964335f,0.000749894185f,0.000649381604f,0.000562341302f,0.000486967532f,0.000421696517f,0.000365174114f,0.000316227757f,0.000273841957f,0.00023713737f,0.00020535251f,0.00017782794f,0.00015399266f,0.00013335215f,0.0001154782f};

constexpr size_t OFF_WA = 0, OFF_WB = (size_t)1024 * 1024, OFF_WO = OFF_WB + (size_t)1024 * 1408, OFF_WG = OFF_WO + (size_t)1024 * 1024, WSM_ELEMS = OFF_WG + (size_t)2 * 16 * 96 * 96;

struct Params {
    const float* x; const int* pos; const float* norm_g; const float* w_in; const float* conv_w; const float* conv_b;
    const float* w_rg; const float* b_rg; const float* w_ig; const float* b_ig; const float* lam;
    const float* w_oa; const float* w_or; const float* w_o; const float* fin_g;
    float* out;
    bf16_t* WinT; bf16_t* Wsm0; bf16_t* Wsm1;
    bf16_t* xb; float* ssq; bf16_t* q; bf16_t* k; bf16_t* v; bf16_t* iq; bf16_t* ik; float* iw; bf16_t* xr; bf16_t* sgr;
    u64* bm; float* agg; unsigned* bar; bf16_t* halo;
};

DEVI unsigned cvtpk(float lo, float hi) { unsigned r; asm volatile("v_cvt_pk_bf16_f32 %0, %1, %2" : "=v"(r) : "v"(lo), "v"(hi)); return r; }
DEVI float bf_lo(unsigned w) { return __uint_as_float(w << 16); }
DEVI float bf_hi(unsigned w) { return __uint_as_float(w & 0xffff0000u); }
DEVI bf16_t f2bf(float f) { return (bf16_t)(cvtpk(f, 0.f) & 0xffffu); }
DEVI float sigmoidf_(float x) { return __builtin_amdgcn_rcpf(1.0f + __expf(-x)); }
DEVI float siluf_(float x) { return x * __builtin_amdgcn_rcpf(1.0f + __expf(-x)); }
DEVI float expm1_small(float x) {
    const float pl = x * (1.0f + x * (0.5f + x * (0.16666667f + x * (0.041666668f + x * 0.0083333338f))));
    float ex = __expf(x) - 1.0f;
    asm volatile("" : "+v"(ex));
    return fabsf(x) < 0.25f ? pl : ex;
}
DEVI int wave_sum_small(int v) {
    int t = 0;
#pragma unroll
    for (int b = 0; b < 7; ++b) t += __popcll(__ballot((v >> b) & 1)) << b;
    return t;
}
DEVI int otid() { int t = threadIdx.x; asm volatile("" : "+v"(t)); return t; }
DEVI float wave_sum(float s) {
#pragma unroll
    for (int o = 32; o > 0; o >>= 1) s += __shfl_xor(s, o);
    return s;
}
DEVI float row_rstd(const float* ssq, int row) {
    const f32x4* p = (const f32x4*)(ssq + (size_t)row * 16);
    const f32x4 a = p[0], b = p[1], c = p[2], d = p[3];
    const float s = ((a[0] + a[1]) + (a[2] + a[3])) + ((b[0] + b[1]) + (b[2] + b[3])) + ((c[0] + c[1]) + (c[2] + c[3])) + ((d[0] + d[1]) + (d[2] + d[3]));
    return rsqrtf(s * (1.0f / 1024.0f) + 1e-6f);
}

namespace pg8 {
constexpr int BM = 256, BK = 64, HALF = 128, HTB = HALF * BK * 2, STAGE_BYTES = 8 * HTB, NXCD = 8, WGM = 8;
DEVI int lds_byte(int r, int c) { const int st = (r >> 4) * 2 + (c >> 5), rr = r & 15, cc = c & 31, ob = rr * 64 + cc * 2; return st * 1024 + (ob ^ (((ob >> 9) & 1) << 5)); }
DEVI void stage_rc(int b, int& R, int& C) { const int st = b / 1024, sb = b % 1024, swz = sb ^ (((sb >> 9) & 1) << 5); R = (st >> 1) * 16 + swz / 64; C = (st & 1) * 32 + (swz % 64) / 2; }
DEVI int perm32(int rho) { const int n = rho >> 4, i = rho & 15; return 8 * (i >> 2) + 4 * n + (i & 3); }
struct Unit { int pm, pn; };
struct Gemm { const bf16_t* A; const bf16_t* Bt; int M, N, K; };
struct StaticOrder {
    int nM, nN, nwg, G, c;
    DEVI void init(int M, int N, int G_, int c_) { nM = M / BM; nN = N / BM; nwg = nM * nN; G = G_; c = c_; }
    DEVI bool next(int i, Unit& u) const {
        const long L = (long)i * G + c; if (L >= nwg) return false;
        int wgid = (int)L; { const int q = nwg / NXCD, r = nwg % NXCD, xcd = wgid % NXCD, off = wgid / NXCD; wgid = (xcd < r ? xcd * (q + 1) : r * (q + 1) + (xcd - r) * q) + off; }
        const int nig = WGM * nN, gid = wgid / nig, fm = gid * WGM, gsz = (nM - fm) < WGM ? (nM - fm) : WGM;
        u.pm = fm + ((wgid % nig) % gsz); u.pn = (wgid % nig) / gsz; return true;
    }
    DEVI void a_ready(const Unit&) const {}
    DEVI void done(const Unit&) const {}
};

template <class Epi, class Sched>
DEVI void gemm_phase(LAS unsigned char* lds, const Gemm g, const Sched& S, const Epi& E) {
    const int tid = otid(), wid = __builtin_amdgcn_readfirstlane(tid >> 6), lane = tid & 63, wr = wid >> 2, wc = wid & 3, fr = lane & 15, fq = lane >> 4;
    const int K = g.K, nt = K / BK;
    unsigned voffA[2], voffB[2];
#pragma unroll
    for (int i = 0; i < 2; ++i) { int R, C; stage_rc(tid * 16 + i * 8192, R, C); const int Rb = Epi::PERM ? ((R & ~31) + perm32(R & 31)) : R;
        voffA[i] = (unsigned)(R * K + C) * 2u; voffB[i] = (unsigned)(Rb * K + C) * 2u; }
    const size_t kstep = (size_t)(BK * 2);
    const size_t hstep = (size_t)HALF * K * 2;
    const size_t tstep = 2 * hstep;
    const unsigned ldsw = (unsigned)wid * 1024u;
    const int aoff = lds_byte(wr * 64 + fr, fq * 8), boff = lds_byte(wc * 32 + fr, fq * 8);
#define PG8_SA(b, h) (((b) * 2 + (h)) * HTB)
#define PG8_SB(b, h) ((4 + (b) * 2 + (h)) * HTB)
#define PG8_STAGE(bufoff, gbase, voff) do { _Pragma("unroll") for (int _i = 0; _i < 2; ++_i) \
        __builtin_amdgcn_global_load_lds((const unsigned*)((const char*)(gbase) + (voff)[_i]), (LAS unsigned*)(lds + (bufoff) + ldsw + _i * 8192), 16, 0, 0); } while (0)
#define PG8_LDA(dst, b, h) do { _Pragma("unroll") for (int m = 0; m < 4; ++m) _Pragma("unroll") for (int k = 0; k < 2; ++k) dst[m][k] = *(const LAS bf16x8*)(lds + PG8_SA(b, h) + aoff + m * 2048 + k * 1024); } while (0)
#define PG8_LDB(dst, b, h) do { _Pragma("unroll") for (int n = 0; n < 2; ++n) _Pragma("unroll") for (int k = 0; k < 2; ++k) dst[n][k] = *(const LAS bf16x8*)(lds + PG8_SB(b, h) + boff + n * 2048 + k * 1024); } while (0)
#define PG8_MMA(ai, bj, At, Bt) do { __builtin_amdgcn_s_setprio(1); _Pragma("unroll") for (int m = 0; m < 4; ++m) _Pragma("unroll") for (int n = 0; n < 2; ++n) _Pragma("unroll") for (int k = 0; k < 2; ++k) \
        acc[ai][bj][m][n] = __builtin_amdgcn_mfma_f32_16x16x32_bf16(Bt[n][k], At[m][k], acc[ai][bj][m][n], 0, 0, 0); __builtin_amdgcn_s_setprio(0); } while (0)
#define PG8_WAIT_V(n) asm volatile("s_waitcnt vmcnt(" #n ")" ::: "memory")
#define PG8_WAIT_L(n) asm volatile("s_waitcnt lgkmcnt(" #n ")" ::: "memory")
#define PG8_BAR __builtin_amdgcn_s_barrier()
#define PG8_SCHED __builtin_amdgcn_sched_barrier(0)
    Unit cur, nxt; int ui = 0;
    if (!S.next(0, cur)) return;
    f32x4 acc[2][2][4][2];
#pragma unroll
    for (int a = 0; a < 2; ++a)
#pragma unroll
        for (int b = 0; b < 2; ++b)
#pragma unroll
            for (int m = 0; m < 4; ++m)
#pragma unroll
                for (int n = 0; n < 2; ++n) acc[a][b][m][n] = (f32x4){0.f, 0.f, 0.f, 0.f};
    bf16x8 At[4][2], B0[2][2], B1[2][2];
    const char* cA = (const char*)g.A + (size_t)cur.pm * tstep; const char* cB = (const char*)g.Bt + (size_t)cur.pn * tstep;
    S.a_ready(cur);
    PG8_STAGE(PG8_SB(0, 0), cB, voffB); PG8_STAGE(PG8_SA(0, 0), cA, voffA); PG8_STAGE(PG8_SB(0, 1), cB + hstep, voffB); PG8_STAGE(PG8_SA(0, 1), cA + hstep, voffA);
    if (wr == 1) PG8_BAR;
    PG8_WAIT_V(4); PG8_BAR;
    PG8_STAGE(PG8_SB(1, 0), cB + kstep, voffB); PG8_STAGE(PG8_SA(1, 0), cA + kstep, voffA); PG8_STAGE(PG8_SB(1, 1), cB + hstep + kstep, voffB);
    PG8_WAIT_V(6); PG8_BAR;
    for (;;) {
        const bool has_next = S.next(ui + 1, nxt);
        const char* nA = has_next ? (const char*)g.A + (size_t)nxt.pm * tstep : cA; const char* nB = has_next ? (const char*)g.Bt + (size_t)nxt.pn * tstep : cB;
        for (int t = 0; t < nt; t += 2) {
            const bool last = (t == nt - 2);
            const char* a1 = cA + (size_t)(t + 1) * kstep;
            const char* a2 = last ? nA : cA + (size_t)(t + 2) * kstep; const char* b2 = last ? nB : cB + (size_t)(t + 2) * kstep;
            const char* a3 = a2 + kstep; const char* b3 = b2 + kstep;
            if (last && has_next) S.a_ready(nxt);
            PG8_LDB(B0, 0, 0); PG8_SCHED; PG8_LDA(At, 0, 0); PG8_STAGE(PG8_SA(1, 1), a1 + hstep, voffA);
            PG8_WAIT_L(8); PG8_BAR; PG8_WAIT_L(0); PG8_MMA(0, 0, At, B0); PG8_BAR; PG8_SCHED;
            PG8_LDB(B1, 0, 1); PG8_STAGE(PG8_SB(0, 0), b2, voffB);
            PG8_BAR; PG8_WAIT_L(0); PG8_MMA(0, 1, At, B1); PG8_BAR;
            PG8_LDA(At, 0, 1); PG8_STAGE(PG8_SA(0, 0), a2, voffA);
            PG8_BAR; PG8_WAIT_L(0); PG8_MMA(1, 0, At, B0); PG8_BAR; PG8_SCHED;
            PG8_STAGE(PG8_SB(0, 1), b2 + hstep, voffB);
            PG8_WAIT_V(6); PG8_BAR; PG8_MMA(1, 1, At, B1); PG8_BAR;
            PG8_LDB(B0, 1, 0); PG8_SCHED; PG8_LDA(At, 1, 0); PG8_STAGE(PG8_SA(0, 1), a2 + hstep, voffA);
            PG8_WAIT_L(8); PG8_BAR; PG8_WAIT_L(0); PG8_MMA(0, 0, At, B0); PG8_BAR; PG8_SCHED;
            PG8_LDB(B1, 1, 1); PG8_STAGE(PG8_SB(1, 0), b3, voffB);
            PG8_BAR; PG8_WAIT_L(0); PG8_MMA(0, 1, At, B1); PG8_BAR;
            PG8_LDA(At, 1, 1); PG8_STAGE(PG8_SA(1, 0), a3, voffA);
            PG8_BAR; PG8_WAIT_L(0); PG8_MMA(1, 0, At, B0); PG8_BAR; PG8_SCHED;
            PG8_STAGE(PG8_SB(1, 1), b3 + hstep, voffB);
            PG8_WAIT_V(6); PG8_BAR; PG8_MMA(1, 1, At, B1); PG8_BAR;
        }
        E(acc, cur, ui, wr, wc, fr, fq); S.done(cur);
        if (!has_next) break;
#pragma unroll
        for (int a = 0; a < 2; ++a)
#pragma unroll
            for (int b = 0; b < 2; ++b)
#pragma unroll
                for (int m = 0; m < 4; ++m)
#pragma unroll
                    for (int n = 0; n < 2; ++n) acc[a][b][m][n] = (f32x4){0.f, 0.f, 0.f, 0.f};
        cur = nxt; cA = nA; cB = nB; ++ui;
    }
    PG8_WAIT_V(0);
    if (wr == 0) PG8_BAR;
    PG8_BAR;
#undef PG8_SA
#undef PG8_SB
#undef PG8_STAGE
#undef PG8_LDA
#undef PG8_LDB
#undef PG8_MMA
#undef PG8_WAIT_V
#undef PG8_WAIT_L
#undef PG8_BAR
#undef PG8_SCHED
}
}
using pg8::Unit;

constexpr int RS_OFF = 131072;
template <class Sched> DEVI void fill_rstd(const float* ssq, const int* pos, const Sched& S, unsigned char* smem) {
    float* rs = (float*)(smem + RS_OFF);
    const int tid = otid(), w = tid >> 6, lane = tid & 63;
    Unit u;
    if (S.next(w, u)) {
#pragma unroll
        for (int rr = 0; rr < 4; rr += 2) {
            const int r0 = lane + 64 * rr, r1 = r0 + 64;
            const f32x4* s0 = (const f32x4*)(ssq + (size_t)(u.pm * 256 + r0) * 16); const f32x4* s1 = (const f32x4*)(ssq + (size_t)(u.pm * 256 + r1) * 16);
            const f32x4 a = s0[0], b = s0[1], c = s0[2], d = s0[3], e = s1[0], f = s1[1], g = s1[2], h = s1[3];
            const int p0 = pos[u.pm * 256 + r0], p1 = pos[u.pm * 256 + r1];
            const float sm0 = ((a[0] + a[1]) + (a[2] + a[3])) + ((b[0] + b[1]) + (b[2] + b[3])) + ((c[0] + c[1]) + (c[2] + c[3])) + ((d[0] + d[1]) + (d[2] + d[3]));
            const float sm1 = ((e[0] + e[1]) + (e[2] + e[3])) + ((f[0] + f[1]) + (f[2] + f[3])) + ((g[0] + g[1]) + (g[2] + g[3])) + ((h[0] + h[1]) + (h[2] + h[3]));
            rs[w * 256 + r0] = rsqrtf(sm0 * (1.0f / 1024.0f) + 1e-6f); rs[w * 256 + r1] = rsqrtf(sm1 * (1.0f / 1024.0f) + 1e-6f);
            rs[2048 + w * 256 + r0] = (float)p0; rs[2048 + w * 256 + r1] = (float)p1;
        }
    }
    __syncthreads();
}
DEVI void store8(bf16_t* p, const f32x4& a, const f32x4& b) { u32x4 w; w.x = cvtpk(a[0], a[1]); w.y = cvtpk(a[2], a[3]); w.z = cvtpk(b[0], b[1]); w.w = cvtpk(b[2], b[3]); *(u32x4*)p = w; }
DEVI void load8f(const bf16_t* p, f32x4& a, f32x4& b) { const u32x4 w = *(const u32x4*)p; a = (f32x4){bf_lo(w.x), bf_hi(w.x), bf_lo(w.y), bf_hi(w.y)}; b = (f32x4){bf_lo(w.z), bf_hi(w.z), bf_lo(w.w), bf_hi(w.w)}; }

struct EpiPA1 {
    static constexpr bool PERM = true;
    const float* rsl; const int* pos; bf16_t* q; bf16_t* k; bf16_t* v; bf16_t* iq; bf16_t* ik; bf16_t* xr; bf16_t* sgr; float* iw; bf16_t* halo;
    DEVI void operator()(const f32x4 (&acc)[2][2][4][2], const Unit& u, int ui, int wr, int wc, int fr, int fq) const {
        const int pn = u.pn, row0 = u.pm * 256 + wr * 64 + fr, o = wc * 32 + 8 * fq;
        const bool rope = (pn < 8) || (pn >= 12 && pn < 16) || (pn == 27);
        if (rope) {
            bf16_t* dst; int ld, c1, c2, fi, fs; bool act = true, isw = false;
            if (pn < 8) { const int hsel = o >> 6, i0 = o & 63, head = 2 * (pn & 3) + hsel; dst = pn < 4 ? q : k; ld = 1024; c1 = head * 128 + i0; c2 = c1 + 64; fi = i0; fs = 1; }
            else if (pn < 16) { const int hsel = o >> 5, i0 = o & 31, head = 4 * (pn - 12) + hsel; dst = iq; ld = 1024; c1 = head * 64 + i0; c2 = c1 + 32; fi = 2 * i0; fs = 2; }
            else { dst = ik; ld = 64; c1 = o & 31; c2 = c1 + 32; fi = 2 * (o & 31); fs = 2; act = (wc == 0); isw = (wc == 1 && fq < 2); }
            float inv[8];
#pragma unroll
            for (int e = 0; e < 8; ++e) inv[e] = c_inv128[(fi + fs * e) & 63] * 0.15915494309189535f;
#pragma unroll
            for (int ai = 0; ai < 2; ++ai)
#pragma unroll
                for (int m = 0; m < 4; ++m) {
                    const int row = row0 + ai * 128 + m * 16; const float rs = rsl[ui * 256 + (row & 255)];
                    if (act) {
                        const float ps = rsl[2048 + ui * 256 + (row & 255)];
                        f32x4 o1[2], o2[2];
#pragma unroll
                        for (int n = 0; n < 2; ++n)
#pragma unroll
                            for (int j = 0; j < 4; ++j) {
                                const float x1 = acc[ai][0][m][n][j] * rs, x2 = acc[ai][1][m][n][j] * rs;
                                const float rev = __builtin_amdgcn_fractf(ps * inv[4 * n + j]);
                                const float sn = __builtin_amdgcn_sinf(rev), cs = __builtin_amdgcn_cosf(rev);
                                o1[n][j] = x1 * cs - x2 * sn; o2[n][j] = x2 * cs + x1 * sn;
                            }
                        store8(dst + (size_t)row * ld + c1, o1[0], o1[1]); store8(dst + (size_t)row * ld + c2, o2[0], o2[1]);
                    } else if (isw) {
                        const float sc = rs * 0.03125f;
                        float* wp = iw + (size_t)row * 16 + 8 * fq;
                        *(f32x4*)wp = acc[ai][0][m][0] * sc; *(f32x4*)(wp + 4) = acc[ai][0][m][1] * sc;
                    }
                }
        } else {
#pragma unroll
            for (int ai = 0; ai < 2; ++ai)
#pragma unroll
                for (int m = 0; m < 4; ++m) {
                    const int row = row0 + ai * 128 + m * 16; const float rs = rsl[ui * 256 + (row & 255)];
#pragma unroll
                    for (int bj = 0; bj < 2; ++bj) {
                        f32x4 a0 = acc[ai][bj][m][0] * rs, a1 = acc[ai][bj][m][1] * rs;
                        if (pn < 12) { store8(v + (size_t)row * 1024 + (pn - 8) * 256 + bj * 128 + o, a0, a1); }
                        else { const int gc = (pn - 16) * 256 + bj * 128 + o;
                            if (gc < DR) { store8(xr + (size_t)row * DR + gc, a0, a1);
                                if ((row & 1023) >= 1021) store8(halo + ((size_t)(row >> 10) * 3 + ((row & 1023) - 1021)) * DR + gc, a0, a1); }
                            else {
#pragma unroll
                                for (int j = 0; j < 4; ++j) { a0[j] = siluf_(a0[j]); a1[j] = siluf_(a1[j]); }
                                store8(sgr + (size_t)row * DR + gc - DR, a0, a1); } }
                    }
                }
        }
    }
};
struct EpiTriv {
    static constexpr bool PERM = true;
    bf16_t* v;
    DEVI void operator()(const f32x4 (&acc)[2][2][4][2], const Unit& u, int ui, int wr, int wc, int fr, int fq) const {
        const int row0 = u.pm * 256 + wr * 64 + fr, o = wc * 32 + 8 * fq;
#pragma unroll
        for (int ai = 0; ai < 2; ++ai)
#pragma unroll
            for (int m = 0; m < 4; ++m) { const int row = row0 + ai * 128 + m * 16;
#pragma unroll
                for (int bj = 0; bj < 2; ++bj) store8(v + (size_t)row * 1024 + (u.pn & 3) * 256 + bj * 128 + o, acc[ai][bj][m][0], acc[ai][bj][m][1]); }
    }
};
struct EpiPA2 {
    static constexpr bool PERM = true;
    const float* rsl; bf16_t* ag; bf16_t* sma; bf16_t* smb;
    DEVI void operator()(const f32x4 (&acc)[2][2][4][2], const Unit& u, int ui, int wr, int wc, int fr, int fq) const {
        const int pn = u.pn, row0 = u.pm * 256 + wr * 64 + fr, o = wc * 32 + 8 * fq;
#pragma unroll
        for (int ai = 0; ai < 2; ++ai) {
            u32x4 gv[4][2];
            if (pn < 4) {
#pragma unroll
                for (int m = 0; m < 4; ++m)
#pragma unroll
                    for (int bj = 0; bj < 2; ++bj) gv[m][bj] = *(const u32x4*)(ag + (size_t)(row0 + ai * 128 + m * 16) * 1024 + (pn & 3) * 256 + bj * 128 + o);
            }
#pragma unroll
            for (int m = 0; m < 4; ++m) {
                const int row = row0 + ai * 128 + m * 16; const float rs = rsl[ui * 256 + (row & 255)];
#pragma unroll
                for (int bj = 0; bj < 2; ++bj) {
                    f32x4 a0 = acc[ai][bj][m][0] * rs, a1 = acc[ai][bj][m][1] * rs;
                    const size_t off = (size_t)row * 1024 + (pn & 3) * 256 + bj * 128 + o;
                    if (pn < 4) { const u32x4 w = gv[m][bj];
                        const f32x4 g0 = {bf_lo(w.x), bf_hi(w.x), bf_lo(w.y), bf_hi(w.y)}, g1 = {bf_lo(w.z), bf_hi(w.z), bf_lo(w.w), bf_hi(w.w)};
#pragma unroll
                        for (int j = 0; j < 4; ++j) { a0[j] = siluf_(a0[j]) * g0[j]; a1[j] = siluf_(a1[j]) * g1[j]; }
                        store8(ag + off, a0, a1); }
                    else {
#pragma unroll
                        for (int j = 0; j < 4; ++j) { a0[j] = sigmoidf_(a0[j]); a1[j] = sigmoidf_(a1[j]); }
                        store8((pn < 8 ? sma : smb) + off, a0, a1); }
                }
            }
        }
    }
};
template <int MODE> struct EpiPD {
    static constexpr bool PERM = true;
    const bf16_t* gate; const bf16_t* yin; bf16_t* outp;
    DEVI void operator()(const f32x4 (&acc)[2][2][4][2], const Unit& u, int ui, int wr, int wc, int fr, int fq) const {
        const int row0 = u.pm * 256 + wr * 64 + fr, o = wc * 32 + 8 * fq;
#pragma unroll
        for (int ai = 0; ai < 2; ++ai) {
            u32x4 gv[4][2], yv[4][2];
#pragma unroll
            for (int m = 0; m < 4; ++m)
#pragma unroll
                for (int bj = 0; bj < 2; ++bj) { const size_t off = (size_t)(row0 + ai * 128 + m * 16) * 1024 + u.pn * 256 + bj * 128 + o;
                    gv[m][bj] = *(const u32x4*)(gate + off); if (MODE == 1) yv[m][bj] = *(const u32x4*)(yin + off); }
#pragma unroll
            for (int m = 0; m < 4; ++m)
#pragma unroll
                for (int bj = 0; bj < 2; ++bj) {
                    const size_t off = (size_t)(row0 + ai * 128 + m * 16) * 1024 + u.pn * 256 + bj * 128 + o;
                    const u32x4 w = gv[m][bj];
                    const f32x4 g0 = {bf_lo(w.x), bf_hi(w.x), bf_lo(w.y), bf_hi(w.y)}, g1 = {bf_lo(w.z), bf_hi(w.z), bf_lo(w.w), bf_hi(w.w)};
                    f32x4 a0 = acc[ai][bj][m][0] * g0, a1 = acc[ai][bj][m][1] * g1;
                    if (MODE == 1) { const u32x4 y = yv[m][bj];
                        a0 += (f32x4){bf_lo(y.x), bf_hi(y.x), bf_lo(y.y), bf_hi(y.y)}; a1 += (f32x4){bf_lo(y.z), bf_hi(y.z), bf_lo(y.w), bf_hi(y.w)}; }
                    store8(outp + off, a0, a1);
                }
        }
    }
};
struct EpiPE {
    static constexpr bool PERM = false;
    const float* xin; float* xout; bf16_t* xb; float* ssq;
    DEVI void operator()(const f32x4 (&acc)[2][2][4][2], const Unit& u, int ui, int wr, int wc, int fr, int fq) const {
        const int row0 = u.pm * 256 + wr * 64 + fr, col0 = u.pn * 256 + wc * 32 + 4 * fq;
#pragma unroll
        for (int ai = 0; ai < 2; ++ai) {
            f32x4 xv[4][2][2];
#pragma unroll
            for (int m = 0; m < 4; ++m)
#pragma unroll
                for (int bj = 0; bj < 2; ++bj)
#pragma unroll
                    for (int n = 0; n < 2; ++n) xv[m][bj][n] = *(const f32x4*)(xin + (size_t)(row0 + ai * 128 + m * 16) * 1024 + col0 + bj * 128 + n * 16);
#pragma unroll
            for (int m = 0; m < 4; ++m) {
                const int row = row0 + ai * 128 + m * 16; float s = 0.f;
#pragma unroll
                for (int bj = 0; bj < 2; ++bj)
#pragma unroll
                    for (int n = 0; n < 2; ++n) {
                        const size_t off = (size_t)row * 1024 + col0 + bj * 128 + n * 16;
                        const f32x4 x2 = xv[m][bj][n] + acc[ai][bj][m][n];
                        *(f32x4*)(xout + off) = x2;
                        u32x2 w; w.x = cvtpk(x2[0], x2[1]); w.y = cvtpk(x2[2], x2[3]); *(u32x2*)(xb + off) = w;
                        s += (x2[0] * x2[0] + x2[1] * x2[1]) + (x2[2] * x2[2] + x2[3] * x2[3]);
                    }
                s += __shfl_xor(s, 16); s += __shfl_xor(s, 32);
                if (fq == 0) ssq[(size_t)row * 16 + u.pn * 4 + wc] = s;
            }
        }
    }
};

namespace at {
constexpr int D = 128, RS = 1024;
constexpr float SCALE = 0.08838834764831845f;
constexpr float THR = 8.f;
constexpr int NW = 8, QBLK = 32, KVBLK = 64, QB = NW * QBLK;
constexpr int SHM_V = KVBLK * D * 2, SHM_K = KVBLK * D * 2;
#define KSWZ(row, colB) ((row) * 256 + ((colB) ^ (((row) & 7) << 4)))
#define SBAR() __builtin_amdgcn_sched_barrier(0)
DEVI int v_st(int k, int c) { const int kk = (k & ~0xC) | ((k & 4) << 1) | ((k & 8) >> 1); return ((kk >> 3) * 4 + (c >> 5)) * 512 + ((kk & 7) * 32 + (c & 31)) * 2; }
DEVI int v_rd_base(int lane) { return ((lane & 3) << 3) | (((lane >> 2) & 3) << 6) | (((lane >> 4) & 1) << 5) | (((lane >> 5) & 1) << 8); }
constexpr int v_rd_off(int d0, int ks, int half) { return d0 * 512 + ks * 4096 + half * 2048; }
DEVI int crow(int r, int hi) { return (r & 3) + 8 * (r >> 2) + 4 * hi; }
DEVI bf16x8 load8(const bf16_t* p) { return *reinterpret_cast<const bf16x8*>(p); }
DEVI void mask_bits(f32x16& p0, f32x16& p1, u64 mw, int hi) {
    const float NEG = -__builtin_inff();
    const unsigned lo = (unsigned)mw >> (4 * hi), hh = (unsigned)(mw >> 32) >> (4 * hi);
#pragma unroll
    for (int r = 0; r < 16; ++r) {
        const int c = (r & 3) + 8 * (r >> 2);
        if (!((lo >> c) & 1u)) p0[r] = NEG;
        if (!((hh >> c) & 1u)) p1[r] = NEG;
    }
}
DEVI void partialSM(f32x16& p0, f32x16& p1, float& m_reg, float& mn, float& alpha) {
    float pmax = p0[0];
#pragma unroll
    for (int r = 1; r < 16; ++r) pmax = fmaxf(pmax, p0[r]);
#pragma unroll
    for (int r = 0; r < 16; ++r) pmax = fmaxf(pmax, p1[r]);
    { auto rr = __builtin_amdgcn_permlane32_swap(__float_as_uint(pmax), __float_as_uint(pmax), false, false);
      pmax = fmaxf(__uint_as_float(rr[0]), __uint_as_float(rr[1])); }
    constexpr float C2 = 1.4426950408889634f * SCALE;
    if (__builtin_expect(__all((pmax - m_reg) * SCALE <= THR), 1)) { mn = m_reg; alpha = 1.f; }
    else { mn = fmaxf(m_reg, pmax); alpha = __builtin_amdgcn_exp2f((m_reg - mn) * C2); m_reg = mn; }
    const float mnL = -mn * C2;
#pragma unroll
    for (int r = 0; r < 16; ++r) p0[r] = fmaf(p0[r], C2, mnL);
#pragma unroll
    for (int r = 0; r < 16; ++r) p1[r] = fmaf(p1[r], C2, mnL);
#pragma unroll
    for (int r = 0; r < 16; ++r) p0[r] = __builtin_amdgcn_exp2f(p0[r]);
}
DEVI void finishSM(f32x16& p0, f32x16& p1, float alpha, float& l_reg, bf16x8& pa0, bf16x8& pa1, bf16x8& pa2, bf16x8& pa3) {
#pragma unroll
    for (int r = 0; r < 16; ++r) p1[r] = __builtin_amdgcn_exp2f(p1[r]);
    float ps = 0;
#pragma unroll
    for (int r = 0; r < 16; ++r) ps += p0[r];
#pragma unroll
    for (int r = 0; r < 16; ++r) ps += p1[r];
    { auto rr = __builtin_amdgcn_permlane32_swap(__float_as_uint(ps), __float_as_uint(ps), false, false);
      ps = __uint_as_float(rr[0]) + __uint_as_float(rr[1]); }
    l_reg = l_reg * alpha + ps;
#define PK4(P, B_, OUT) do { unsigned a0 = cvtpk(P[B_+0], P[B_+1]), a1 = cvtpk(P[B_+2], P[B_+3]);                          \
        unsigned b0 = cvtpk(P[B_+4], P[B_+5]), b1 = cvtpk(P[B_+6], P[B_+7]);                                             \
        auto r0 = __builtin_amdgcn_permlane32_swap(a0, b0, false, false); auto r1 = __builtin_amdgcn_permlane32_swap(a1, b1, false, false); \
        u32x4 w = {r0[0], r1[0], r0[1], r1[1]}; OUT = *reinterpret_cast<bf16x8*>(&w); } while (0)
    PK4(p0, 0, pa0); PK4(p0, 8, pa1); PK4(p1, 0, pa2); PK4(p1, 8, pa3);
#undef PK4
}
template <int KB>
DEVI void qkt(f32x16& p0, f32x16& p1, const char* K_lds, int r32, int hi, const LAS unsigned char* qb) {
    p0 = f32x16{}; p1 = f32x16{};
    const char* kb[4];
#pragma unroll
    for (int dd = 0; dd < 4; ++dd) kb[dd] = K_lds + KB * SHM_K + KSWZ(r32, (dd * 16 + hi * 8) * 2);
#pragma unroll
    for (int d0 = 0; d0 < 8; ++d0) { const char* a = kb[d0 & 3] + (d0 >> 2) * 128;
        bf16x8 b0 = *reinterpret_cast<const bf16x8*>(a);
        bf16x8 b1 = *reinterpret_cast<const bf16x8*>(a + 32 * 256);
        const bf16x8 qf = *(const LAS bf16x8*)(qb + d0 * 1024);
        p0 = __builtin_amdgcn_mfma_f32_32x32x16_bf16(b0, qf, p0, 0, 0, 0);
        p1 = __builtin_amdgcn_mfma_f32_32x32x16_bf16(b1, qf, p1, 0, 0, 0); }
}
template <int VB>
DEVI void pv_tile(f32x16* o, int vb0, bf16x8 pa0, bf16x8 pa1, bf16x8 pa2, bf16x8 pa3) {
#define TRRD(dst, off) asm volatile("ds_read_b64_tr_b16 %0, %1 offset:%2" : "=&v"(dst) : "v"(vb0), "i"(off) : "memory")
#define PV_D0(d0) do { s16x4 l0, l1, l2, l3, h0, h1, h2, h3; constexpr int b_ = VB * SHM_V + v_rd_off(d0, 0, 0); \
        TRRD(l0, b_); TRRD(h0, b_ + 2048); TRRD(l1, b_ + 4096); TRRD(h1, b_ + 6144); TRRD(l2, b_ + 8192); TRRD(h2, b_ + 10240); TRRD(l3, b_ + 12288); TRRD(h3, b_ + 14336); \
        asm volatile("s_waitcnt lgkmcnt(0)" ::: "memory"); SBAR();   \
        o[d0] = __builtin_amdgcn_mfma_f32_32x32x16_bf16(pa0, (bf16x8){l0[0], l0[1], l0[2], l0[3], h0[0], h0[1], h0[2], h0[3]}, o[d0], 0, 0, 0);   \
        o[d0] = __builtin_amdgcn_mfma_f32_32x32x16_bf16(pa1, (bf16x8){l1[0], l1[1], l1[2], l1[3], h1[0], h1[1], h1[2], h1[3]}, o[d0], 0, 0, 0);   \
        o[d0] = __builtin_amdgcn_mfma_f32_32x32x16_bf16(pa2, (bf16x8){l2[0], l2[1], l2[2], l2[3], h2[0], h2[1], h2[2], h2[3]}, o[d0], 0, 0, 0);   \
        o[d0] = __builtin_amdgcn_mfma_f32_32x32x16_bf16(pa3, (bf16x8){l3[0], l3[1], l3[2], l3[3], h3[0], h3[1], h3[2], h3[3]}, o[d0], 0, 0, 0); } while (0)
    PV_D0(0); PV_D0(1); PV_D0(2); PV_D0(3);
#undef PV_D0
#undef TRRD
}
struct BlockRef { const bf16_t* Q; const bf16_t* K; const bf16_t* V; bf16_t* O; const u64* M; int P0; };
struct Stg { bf16x8 st_v0, st_v1, st_k0, st_k1; };
constexpr int MOFF = 2 * SHM_V + 2 * SHM_K + NW * 64 * 4, QOFF = MOFF + 4096;
#define ROW(p, k0, rr) ((p) + (size_t)((k0) + (rr)) * RS + sc)
#define VMW() asm volatile("s_waitcnt vmcnt(0)" ::: "memory")
#define VMWN(n) asm volatile("s_waitcnt vmcnt(%0)" :: "i"(n) : "memory")
#define SLOAD_H(Kp, Vp, k0) do { S.st_v0 = load8(ROW(Vp, k0, sr)); S.st_v1 = load8(ROW(Vp, k0, 32 + sr));              \
                         S.st_k0 = load8(ROW(Kp, k0, sr)); S.st_k1 = load8(ROW(Kp, k0, 32 + sr)); } while (0)
#define SWRITE_HK(bf) do { *(bf16x8*)(K_lds + (bf) * SHM_K + kws) = S.st_k0; *(bf16x8*)(K_lds + (bf) * SHM_K + kws + 32 * 256) = S.st_k1; } while (0)
#define SWRITE_HV(bf) do { *(bf16x8*)(V_lds + (bf) * SHM_V + vst0) = S.st_v0; *(bf16x8*)(V_lds + (bf) * SHM_V + vst1) = S.st_v1; } while (0)
#define SWRITE_H(bf) do { SWRITE_HV(bf); SWRITE_HK(bf); } while (0)
DEVI void attn_block(const BlockRef& cur, char* lds) {
    const int tid = otid(), wid = __builtin_amdgcn_readfirstlane(tid >> 6), lane = tid & 63, r32 = lane & 31, hi = lane >> 5;
    const int NT = (cur.P0 + QB - 1) / KVBLK + 1;
    char* V_lds = lds; char* K_lds = lds + 2 * SHM_V;
    float* ws = (float*)(lds + 2 * SHM_V + 2 * SHM_K) + wid * 64; float* li_l = ws, * al_l = ws + 32;
    float m_reg = -1e30f, l_reg = 0; f32x16 o[4] = {};
    const int sr = tid >> 4, sc = (tid & 15) * 8, vst0 = v_st(sr, sc), vst1 = v_st(32 + sr, sc), kws = KSWZ(sr, sc * 2);
    const int vb0 = (int)(uintptr_t)V_lds + v_rd_base(lane);
    const bf16_t* Kh = cur.K; const bf16_t* Vh = cur.V;
    const char* Mu = (const char*)(cur.M + cur.P0 + wid * QBLK);
    const unsigned lane4 = (unsigned)lane * 4u;
    LAS unsigned char* mlds = (LAS unsigned char*)(lds + MOFF) + wid * 256;
    LAS unsigned char* qb = (LAS unsigned char*)(lds + QOFF) + wid * 8192 + lane * 16;
    Stg S;
#define RESC(a) do { if (__any((a) < 1.f)) { if (hi == 0) al_l[r32] = (a); asm volatile("s_waitcnt lgkmcnt(0)" ::: "memory");              \
                     for (int d_ = 0; d_ < 4; ++d_) for (int r = 0; r < 16; ++r) o[d_][r] *= al_l[crow(r, hi)]; } } while (0)
#define KBASE(t) ((t) * KVBLK)
#define MLOAD(t) do { __builtin_amdgcn_global_load_lds((const unsigned*)(Mu + (size_t)(t) * 32768 + lane4), (LAS unsigned*)(mlds + ((t) & 1) * 2048), 4, 0, 0); } while (0)
#define MASKT(P0_, P1_, t) do { const u64 mw_ = *(const LAS u64*)(mlds + ((t) & 1) * 2048 + r32 * 8); mask_bits(P0_, P1_, mw_, hi); } while (0)
    f32x16 pA0, pA1, pB0, pB1; float mnA, mnB, alA, alB; bf16x8 pa0, pa1, pa2, pa3;
    {
#pragma unroll
        for (int d0 = 0; d0 < 8; ++d0) { const bf16x8 qf = load8(cur.Q + (size_t)(wid * QBLK + r32) * RS + d0 * 16 + hi * 8); *(LAS bf16x8*)(qb + d0 * 1024) = qf; }
        SLOAD_H(Kh, Vh, 0); VMW(); SWRITE_H(0);
    }
    MLOAD(0);
    SLOAD_H(Kh, Vh, KBASE(1));
    __syncthreads();
    SBAR(); qkt<0>(pA0, pA1, K_lds, r32, hi, qb);
    VMWN(4);
    MASKT(pA0, pA1, 0); partialSM(pA0, pA1, m_reg, mnA, alA);
    VMW(); SWRITE_H(1);
    __syncthreads();
#define HALF_STEP(PX0, PX1, mnX, alX, PY0, PY1, alY, t, KB, VB, SB) do {                                                      \
        MLOAD(t);                                                                                                             \
        SBAR(); qkt<KB>(PX0, PX1, K_lds, r32, hi, qb);                                                                       \
        finishSM(PY0, PY1, alY, l_reg, pa0, pa1, pa2, pa3); SBAR();                                                           \
        if ((t) + 1 < NT) { SLOAD_H(Kh, Vh, KBASE((t) + 1)); SBAR(); }                                                        \
        pv_tile<VB>(o, vb0, pa0, pa1, pa2, pa3);                                                                              \
        if ((t) + 1 < NT) VMWN(4); else VMW();                                                                                \
        MASKT(PX0, PX1, t); partialSM(PX0, PX1, m_reg, mnX, alX);                                                             \
        __syncthreads();                                                                                                      \
        if ((t) + 1 < NT) { VMW(); SWRITE_H(SB); }                                                                            \
        RESC(alX); __syncthreads(); } while (0)
    for (int t = 1; t + 1 < NT; t += 2) {
        HALF_STEP(pB0, pB1, mnB, alB, pA0, pA1, alA, t, 1, 0, 0);
        HALF_STEP(pA0, pA1, mnA, alA, pB0, pB1, alB, t + 1, 0, 1, 1);
    }
    const bool even = (NT & 1) == 0;
    if (even) { MLOAD(NT - 1); SBAR(); qkt<1>(pB0, pB1, K_lds, r32, hi, qb); SBAR(); }
    finishSM(pA0, pA1, alA, l_reg, pa0, pa1, pa2, pa3); SBAR();
    pv_tile<0>(o, vb0, pa0, pa1, pa2, pa3);
    if (even) { VMW(); MASKT(pB0, pB1, NT - 1); partialSM(pB0, pB1, m_reg, mnB, alB); __syncthreads(); RESC(alB);
        finishSM(pB0, pB1, alB, l_reg, pa0, pa1, pa2, pa3); SBAR(); pv_tile<1>(o, vb0, pa0, pa1, pa2, pa3); }
    SBAR();
    if (hi == 0) li_l[r32] = l_reg; asm volatile("s_waitcnt lgkmcnt(0)" ::: "memory");
    float rli[16];
#pragma unroll
    for (int r = 0; r < 16; ++r) rli[r] = __builtin_amdgcn_rcpf(li_l[crow(r, hi)]);
    bf16_t* Ow = cur.O + (size_t)(wid * QBLK) * RS;
#pragma unroll
    for (int r = 0; r < 16; ++r) { const int orow = crow(r, hi);
#pragma unroll
        for (int d0 = 0; d0 < 4; ++d0) { const float v = o[d0][r] * rli[r];
            const float vn = __shfl_xor(v, 1);
            if ((r32 & 1) == 0) *(unsigned*)(Ow + (size_t)orow * RS + d0 * 32 + r32) = cvtpk(v, vn); } }
    __syncthreads();
#undef RESC
#undef KBASE
#undef MLOAD
#undef MASKT
#undef HALF_STEP
}
#undef ROW
#undef VMW
#undef VMWN
#undef SLOAD_H
#undef SWRITE_HK
#undef SWRITE_HV
#undef SWRITE_H
}

DEVI at::BlockRef attn_ref(const Params& p, int bh, int qb, bf16_t* obase) {
    const int b = bh >> 3, h = bh & 7; at::BlockRef r;
    const size_t base = (size_t)b * S * 1024 + h * 128;
    r.Q = p.q + base + (size_t)qb * 256 * 1024; r.O = obase + base + (size_t)qb * 256 * 1024;
    r.K = p.k + base; r.V = p.v + base; r.M = p.bm + (size_t)b * 64 * S; r.P0 = qb * 256;
    return r;
}
DEVI void phase_attention(const Params& p, unsigned char* smem, bf16_t* obase) {
    const int total = 256, G = gridDim.x;
    for (int c = blockIdx.x; c < total; c += G) {
        const int L = (G == 256) ? ((c & 7) * 32 + (c >> 3)) : c;
        const int bh = L >> 3, x = L & 7;
        at::attn_block(attn_ref(p, bh, 15 - x, obase), (char*)smem);
        at::attn_block(attn_ref(p, bh, x, obase), (char*)smem);
    }
}

DEVI void idx_cnt8(int& cl, unsigned cand, unsigned k0, unsigned k1, unsigned k2, unsigned k3, unsigned k4, unsigned k5, unsigned k6, unsigned k7) {
    u64 m0, m1, m2, m3, m4, m5, m6, m7;
    asm volatile(
        "v_cmp_le_u32_e64 %[m0], %[c], %[k0]\n\tv_cmp_le_u32_e64 %[m1], %[c], %[k1]\n\tv_cmp_le_u32_e64 %[m2], %[c], %[k2]\n\tv_cmp_le_u32_e64 %[m3], %[c], %[k3]\n\t"
        "v_cmp_le_u32_e64 %[m4], %[c], %[k4]\n\tv_cmp_le_u32_e64 %[m5], %[c], %[k5]\n\tv_cmp_le_u32_e64 %[m6], %[c], %[k6]\n\tv_cmp_le_u32_e64 %[m7], %[c], %[k7]\n\t"
        "v_addc_co_u32_e64 %[cl], %[m0], 0, %[cl], %[m0]\n\tv_addc_co_u32_e64 %[cl], %[m1], 0, %[cl], %[m1]\n\tv_addc_co_u32_e64 %[cl], %[m2], 0, %[cl], %[m2]\n\tv_addc_co_u32_e64 %[cl], %[m3], 0, %[cl], %[m3]\n\t"
        "v_addc_co_u32_e64 %[cl], %[m4], 0, %[cl], %[m4]\n\tv_addc_co_u32_e64 %[cl], %[m5], 0, %[cl], %[m5]\n\tv_addc_co_u32_e64 %[cl], %[m6], 0, %[cl], %[m6]\n\tv_addc_co_u32_e64 %[cl], %[m7], 0, %[cl], %[m7]\n\ts_nop 1"
        : [cl] "+v"(cl), [m0] "=&s"(m0), [m1] "=&s"(m1), [m2] "=&s"(m2), [m3] "=&s"(m3), [m4] "=&s"(m4), [m5] "=&s"(m5), [m6] "=&s"(m6), [m7] "=&s"(m7)
        : [c] "s"(cand), [k0] "v"(k0), [k1] "v"(k1), [k2] "v"(k2), [k3] "v"(k3), [k4] "v"(k4), [k5] "v"(k5), [k6] "v"(k6), [k7] "v"(k7));
}
template <int BASE>
DEVI void idx_emit8(unsigned& mlo, unsigned& mhi, unsigned T_, unsigned k0, unsigned k1, unsigned k2, unsigned k3, unsigned k4, unsigned k5, unsigned k6, unsigned k7) {
    u64 m0, m1, m2, m3, m4, m5, m6, m7;
    asm volatile(
        "v_cmp_lt_u32_e64 %[m0], %[c], %[k0]\n\tv_cmp_lt_u32_e64 %[m1], %[c], %[k1]\n\tv_cmp_lt_u32_e64 %[m2], %[c], %[k2]\n\tv_cmp_lt_u32_e64 %[m3], %[c], %[k3]\n\t"
        "v_cmp_lt_u32_e64 %[m4], %[c], %[k4]\n\tv_cmp_lt_u32_e64 %[m5], %[c], %[k5]\n\tv_cmp_lt_u32_e64 %[m6], %[c], %[k6]\n\tv_cmp_lt_u32_e64 %[m7], %[c], %[k7]\n\ts_nop 3"
        : [m0] "=&s"(m0), [m1] "=&s"(m1), [m2] "=&s"(m2), [m3] "=&s"(m3), [m4] "=&s"(m4), [m5] "=&s"(m5), [m6] "=&s"(m6), [m7] "=&s"(m7)
        : [c] "s"(T_), [k0] "v"(k0), [k1] "v"(k1), [k2] "v"(k2), [k3] "v"(k3), [k4] "v"(k4), [k5] "v"(k5), [k6] "v"(k6), [k7] "v"(k7));
    asm volatile(
        "s_nop 3\n\t"
        "v_writelane_b32 %[lo], %[a0], %[i0]\n\tv_writelane_b32 %[hi], %[b0], %[i0]\n\tv_writelane_b32 %[lo], %[a1], %[i1]\n\tv_writelane_b32 %[hi], %[b1], %[i1]\n\t"
        "v_writelane_b32 %[lo], %[a2], %[i2]\n\tv_writelane_b32 %[hi], %[b2], %[i2]\n\tv_writelane_b32 %[lo], %[a3], %[i3]\n\tv_writelane_b32 %[hi], %[b3], %[i3]\n\t"
        "v_writelane_b32 %[lo], %[a4], %[i4]\n\tv_writelane_b32 %[hi], %[b4], %[i4]\n\tv_writelane_b32 %[lo], %[a5], %[i5]\n\tv_writelane_b32 %[hi], %[b5], %[i5]\n\t"
        "v_writelane_b32 %[lo], %[a6], %[i6]\n\tv_writelane_b32 %[hi], %[b6], %[i6]\n\tv_writelane_b32 %[lo], %[a7], %[i7]\n\tv_writelane_b32 %[hi], %[b7], %[i7]\n\ts_nop 1"
        : [lo] "+v"(mlo), [hi] "+v"(mhi)
        : [a0] "s"((unsigned)m0), [b0] "s"((unsigned)(m0 >> 32)), [a1] "s"((unsigned)m1), [b1] "s"((unsigned)(m1 >> 32)), [a2] "s"((unsigned)m2), [b2] "s"((unsigned)(m2 >> 32)),
          [a3] "s"((unsigned)m3), [b3] "s"((unsigned)(m3 >> 32)), [a4] "s"((unsigned)m4), [b4] "s"((unsigned)(m4 >> 32)), [a5] "s"((unsigned)m5), [b5] "s"((unsigned)(m5 >> 32)),
          [a6] "s"((unsigned)m6), [b6] "s"((unsigned)(m6 >> 32)), [a7] "s"((unsigned)m7), [b7] "s"((unsigned)(m7 >> 32)),
          [i0] "n"(BASE), [i1] "n"(BASE + 1), [i2] "n"(BASE + 2), [i3] "n"(BASE + 3), [i4] "n"(BASE + 4), [i5] "n"(BASE + 5), [i6] "n"(BASE + 6), [i7] "n"(BASE + 7));
}
DEVI int idx_count(const unsigned (&kv)[64], int ni, unsigned cand) {
    int cl = 0;
    cand = (unsigned)__builtin_amdgcn_readfirstlane((int)cand);
#pragma unroll
    for (int g8 = 0; g8 < 8; ++g8) {
        if (g8 * 8 < ni) idx_cnt8(cl, cand, kv[g8 * 8], kv[g8 * 8 + 1], kv[g8 * 8 + 2], kv[g8 * 8 + 3], kv[g8 * 8 + 4], kv[g8 * 8 + 5], kv[g8 * 8 + 6], kv[g8 * 8 + 7]);
    }
    return wave_sum_small(cl);
}
struct IdxPre { u32x4 av[2]; unsigned iv[16]; f32x4 w4v[4]; float wv; bf16x8 b0[4], b1[4], b2[4]; };
DEVI void idx_issue(const Params& p, int u, IdxPre& R) {
    const int tid = otid(), wid = __builtin_amdgcn_readfirstlane(tid >> 6), lane = tid & 63, r32 = lane & 31, hi = lane >> 5;
    const int slot = u & 255, ii = u >> 8, b = ii >> 1, g = (ii & 1) ? 511 - slot : slot, t0 = g * 8;
    const size_t tokb = (size_t)b * S;
    if (t0 + 8 > 256) {
        R.wv = 0.5f * p.iw[(tokb + t0) * 16 + (tid & 127)];
        { const int qq = tid >> 6, d = tid & 63;
          const f32x4* wp = (const f32x4*)(p.iw + (tokb + t0 + qq) * 16); const bf16_t* ip = p.iq + (tokb + t0 + qq) * 1024 + d;
#pragma unroll
          for (int h = 0; h < 16; ++h) R.iv[h] = ip[h * 64];
#pragma unroll
          for (int i = 0; i < 4; ++i) R.w4v[i] = wp[i]; }
#pragma unroll
        for (int e = 0; e < 2; ++e) { const int cid = tid + 512 * e, rt = cid >> 8, s4 = (cid >> 6) & 3, ln = cid & 63, rr = ln & 31, hh = ln >> 5;
            const int qs = (rr >> 2) & 1, hd = (rr & 3) | ((rr >> 3) << 2);
            R.av[e] = *(const u32x4*)(p.iq + (tokb + t0 + 2 * rt + qs) * 1024 + hd * 64 + s4 * 16 + hh * 8); }
        const int ntile = ((t0 + 8 + 63) >> 6) * 2;
        const bf16_t* kbase = p.ik + tokb * 64 + (size_t)r32 * 64 + hi * 8;
#pragma unroll
        for (int s = 0; s < 4; ++s) { const int k0 = wid < ntile ? wid : ntile - 1, k1 = wid + 8 < ntile ? wid + 8 : ntile - 1, k2 = wid + 16 < ntile ? wid + 16 : ntile - 1;
            R.b0[s] = *(const bf16x8*)(kbase + (size_t)k0 * 2048 + s * 16); R.b1[s] = *(const bf16x8*)(kbase + (size_t)k1 * 2048 + s * 16); R.b2[s] = *(const bf16x8*)(kbase + (size_t)k2 * 2048 + s * 16); }
    }
}
DEVI void idx_unit(const Params& p, int u, int un, IdxPre& R, unsigned char* smem) {
    const int tid = otid(), wid = __builtin_amdgcn_readfirstlane(tid >> 6), lane = tid & 63;
    const int slot = u & 255, ii = u >> 8, b = ii >> 1, g = (ii & 1) ? 511 - slot : slot, t0 = g * 8;
    unsigned* keys = (unsigned*)smem;
    u64* wl = (u64*)(smem + 131072);
    float* wvl = (float*)(smem + 135168);
    const size_t tokb = (size_t)b * S;
    const int nk64 = (t0 + 8 + 63) >> 6;
    if (t0 + 8 > 256) {
        const int r32 = lane & 31, hi = lane >> 5;
        bf16_t* lin = (bf16_t*)(smem + 135680);
        if (tid < 128) wvl[tid] = R.wv;
        { const int qq = tid >> 6, d = tid & 63;
          float a = 0.f;
#pragma unroll
          for (int i = 0; i < 4; ++i)
#pragma unroll
              for (int jx = 0; jx < 4; ++jx) a = fmaf(0.5f * R.w4v[i][jx], __uint_as_float(R.iv[4 * i + jx] << 16), a);
          const bf16_t hb = f2bf(a); const float rem = a - __uint_as_float((unsigned)hb << 16);
          lin[qq * 64 + d] = hb; lin[512 + qq * 64 + d] = f2bf(rem); if (tid < 64) lin[1024 + tid] = 0; }
        bf16_t* afl = (bf16_t*)(smem + 137984);
#pragma unroll
        for (int e = 0; e < 2; ++e) *(u32x4*)(afl + (tid + 512 * e) * 8) = R.av[e];
        const int ntile = nk64 * 2;
        const bf16_t* kbase = p.ik + tokb * 64 + (size_t)r32 * 64 + hi * 8;
#define IDX_LOADB(dst, kq) do { const int kk_ = (kq) < ntile ? (kq) : ntile - 1; _Pragma("unroll") for (int s = 0; s < 4; ++s) dst[s] = *(const bf16x8*)(kbase + (size_t)kk_ * 2048 + s * 16); } while (0)
        __syncthreads();
        const bf16_t* afp = afl + lane * 8;
        const bf16_t* a5p = lin + ((r32 < 16) ? ((r32 >> 3) * 512 + (2 * (r32 & 3) + ((r32 >> 2) & 1)) * 64 + hi * 8) : 1024);
#define IDX_AF(rt, s) (*(const bf16x8*)(afp + ((rt) * 4 + (s)) * 512))
#define IDX_M1(bc) do { acc0 = f32x16{}; acc1 = f32x16{}; acc5 = f32x16{};                                                    \
            _Pragma("unroll") for (int s = 0; s < 4; ++s) {                                                                    \
                acc0 = __builtin_amdgcn_mfma_f32_32x32x16_bf16(IDX_AF(0, s), bc[s], acc0, 0, 0, 0);                           \
                acc1 = __builtin_amdgcn_mfma_f32_32x32x16_bf16(IDX_AF(1, s), bc[s], acc1, 0, 0, 0);                           \
                acc5 = __builtin_amdgcn_mfma_f32_32x32x16_bf16(*(const bf16x8*)(a5p + s * 16), bc[s], acc5, 0, 0, 0); }      \
            __builtin_amdgcn_sched_barrier(0); } while (0)
#define IDX_M2(bc) do { acc2 = f32x16{}; acc3 = f32x16{};                                                                     \
            _Pragma("unroll") for (int s = 0; s < 4; ++s) {                                                                    \
                acc2 = __builtin_amdgcn_mfma_f32_32x32x16_bf16(IDX_AF(2, s), bc[s], acc2, 0, 0, 0);                           \
                acc3 = __builtin_amdgcn_mfma_f32_32x32x16_bf16(IDX_AF(3, s), bc[s], acc3, 0, 0, 0); }                         \
            __builtin_amdgcn_sched_barrier(0); } while (0)
#define IDX_EPI(ACC, LIN, rt, kt_) do {                                                                                     \
                const int myq = 2 * (rt) + hi, key = (kt_) * 32 + r32;                                                        \
                const f32x4* wp = (const f32x4*)(wvl + myq * 16);                                                             \
                float sc = (LIN);                                                                                             \
                _Pragma("unroll") for (int i = 0; i < 4; ++i) { const f32x4 w4 = wp[i];                                       \
                    _Pragma("unroll") for (int jx = 0; jx < 4; ++jx) sc = fmaf(w4[jx], fabsf(ACC[4 * i + jx]), sc); }         \
                const unsigned bits = __float_as_uint(sc);                                                                    \
                unsigned kk = bits ^ ((unsigned)((int)bits >> 31) | 0x80000000u);                                             \
                if (key > t0 + myq) kk = 0u;                                                                                  \
                keys[myq * 4096 + key] = kk; } while (0)
#define IDX_E1(kt_) do { lin2 = acc5[2] + acc5[6]; lin3 = acc5[3] + acc5[7];                                                  \
            IDX_EPI(acc0, acc5[0] + acc5[4], 0, kt_); IDX_EPI(acc1, acc5[1] + acc5[5], 1, kt_); __builtin_amdgcn_sched_barrier(0); } while (0)
#define IDX_E2(kt_) do { IDX_EPI(acc2, lin2, 2, kt_); IDX_EPI(acc3, lin3, 3, kt_); __builtin_amdgcn_sched_barrier(0); } while (0)
#define IDX_STEP(bx, by) { IDX_M2(bx); IDX_LOADB(bx, kt + 24); __builtin_amdgcn_sched_barrier(0); IDX_E1(kt);                  \
            const bool more_ = kt + 8 < ntile; if (more_) IDX_M1(by); IDX_E2(kt); kt += 8; if (!more_) break; }
        {
            f32x16 acc0, acc1, acc2, acc3, acc5; float lin2, lin3;
            int kt = wid;
            if (kt < ntile) {
                IDX_M1(R.b0);
                for (;;) { IDX_STEP(R.b0, R.b1) IDX_STEP(R.b1, R.b2) IDX_STEP(R.b2, R.b0) }
            }
        }
#undef IDX_STEP
#undef IDX_E2
#undef IDX_E1
#undef IDX_EPI
#undef IDX_M2
#undef IDX_M1
#undef IDX_AF
#undef IDX_LOADB
    }
    __syncthreads();
    if (un >= 0) idx_issue(p, un, R);
#pragma unroll 1
    for (int rep = 0; rep < 1 + (PROBE_REP == 9); ++rep)
    {
        const int tq = t0 + wid, n = tq + 1;
        u64 myword = 0;
        if (n <= 256) {
            const int lo = lane * 64;
            myword = (tq >= lo + 63) ? ~0ull : (tq < lo ? 0ull : ((1ull << (tq - lo + 1)) - 1ull));
        } else {
            const int ni = (n + 63) >> 6;
            unsigned kv[64];
#pragma unroll
            for (int i = 0; i < 64; ++i) { const unsigned vv = keys[wid * 4096 + i * 64 + lane]; kv[i] = (i < ni) ? vv : 0u; }
            unsigned kmax = 0;
#pragma unroll
            for (int i = 0; i < 64; ++i) kmax = kv[i] > kmax ? kv[i] : kmax;
#pragma unroll
            for (int o = 32; o > 0; o >>= 1) { const unsigned ot = (unsigned)__shfl_xor((int)kmax, o); kmax = ot > kmax ? ot : kmax; }
            kmax = (unsigned)__builtin_amdgcn_readfirstlane((int)kmax);
            unsigned lo = 1u, hi = kmax + 1u; int c_lo = n, c_hi = 0; bool exact = false;
            { unsigned cand = kmax & 0xFF800000u;
#pragma unroll 1
              for (int st = 0; st < 4 && cand >= 0x00800000u; ++st) {
                  const int c = idx_count(kv, ni, cand);
                  if (c >= 256) { lo = cand; c_lo = c; exact = (c == 256); break; }
                  hi = cand; c_hi = c; cand -= 0x00800000u;
              } }
            if (!exact) {
#pragma unroll 1
                while (hi - lo > 1u && c_lo - c_hi > 64) {
                    const unsigned mid = lo + ((hi - lo) >> 1);
                    const int c = idx_count(kv, ni, mid);
                    if (c == 256) { lo = mid; exact = true; break; }
                    if (c > 256) { lo = mid; c_lo = c; } else { hi = mid; c_hi = c; }
                }
            }
            if (!exact && hi - lo > 1u) {
                unsigned* slot = (unsigned*)(wl + wid * 64);
                int base = 0; const unsigned span = hi - lo;
#pragma unroll
                for (int i = 0; i < 64; ++i) {
                    const bool inb = (kv[i] - lo) < span;
                    const u64 bb = __ballot(inb);
                    if (bb != 0ull) {
                        const int off = base + (int)__builtin_amdgcn_mbcnt_hi((unsigned)(bb >> 32), __builtin_amdgcn_mbcnt_lo((unsigned)bb, 0u));
                        if (inb) slot[off] = kv[i];
                        base += __popcll(bb);
                    }
                }
                const unsigned mine = (lane < base) ? slot[lane] : 0u;
                const int c_above = c_hi;
#pragma unroll 1
                while (hi - lo > 1u) {
                    const unsigned mid = lo + ((hi - lo) >> 1);
                    const int c = c_above + __popcll(__ballot(mine >= mid));
                    if (c == 256) { lo = mid; exact = true; break; }
                    if (c > 256) { lo = mid; c_lo = c; } else { hi = mid; c_hi = c; }
                }
            }
            const unsigned prefix = lo;
            unsigned Tt; int need;
            if (exact) { Tt = prefix - 1u; need = 0; }
            else { Tt = prefix; need = 256 - c_hi; }
            if (need == 0) {
                unsigned mlo = 0u, mhi = 0u; const unsigned Ts = (unsigned)__builtin_amdgcn_readfirstlane((int)Tt);
#define EMIT8(G) idx_emit8<G * 8>(mlo, mhi, Ts, kv[G * 8], kv[G * 8 + 1], kv[G * 8 + 2], kv[G * 8 + 3], kv[G * 8 + 4], kv[G * 8 + 5], kv[G * 8 + 6], kv[G * 8 + 7])
                EMIT8(0); EMIT8(1); EMIT8(2); EMIT8(3); EMIT8(4); EMIT8(5); EMIT8(6); EMIT8(7);
#undef EMIT8
                myword = ((u64)mhi << 32) | mlo;
            } else {
#pragma unroll
                for (int i = 0; i < 64; ++i) {
                    u64 m = __ballot(kv[i] > Tt);
                    if (need > 0) {
                        u64 me = __ballot(kv[i] == Tt);
                        const int pc = __popcll(me), take = pc < need ? pc : need;
                        while (__popcll(me) > take) me &= ~(1ull << (63 - __clzll(me)));
                        need -= take; m |= me;
                    }
                    if (lane == i) myword = m;
                }
            }
        }
        wl[wid * 64 + lane] = myword;
    }
    __syncthreads();
    { const int jj = tid >> 3, qq = tid & 7; p.bm[((size_t)b * 64 + jj) * S + t0 + qq] = wl[qq * 64 + jj]; }
    __syncthreads();
}

constexpr int RL_XIN = 0, RL_XCU = 46592, RL_XA = 91648, RL_SAGG = 116224, RL_CAR = 119040, RL_HALO = 120448, RL_CONST = 121600, RL_WG = 124544, RL_WSTR = 104;
DEVI void rnn_quarter(const Params& p, int l, int sq, unsigned char* smem, bool dry) {
    const int tid = otid(), wid = __builtin_amdgcn_readfirstlane(tid >> 6), lane = tid & 63;
    const int n = sq & 15, q = (sq >> 4) & 3, b = sq >> 6;
    float* xin = (float*)(smem + RL_XIN);
    float* xcu = (float*)(smem + RL_XCU);
    bf16_t* xa = (bf16_t*)(smem + RL_XA);
    f32x2* sagg = (f32x2*)(smem + RL_SAGG);
    f32x2* car = (f32x2*)(smem + RL_CAR);
    float* halo = (float*)(smem + RL_HALO);
    float* cst = (float*)(smem + RL_CONST);
    bf16_t* wg = (bf16_t*)(smem + RL_WG);
    const int fr = lane & 15, fq = lane >> 4;
    const int sc_ = tid % 88, sg = tid / 88;
    {
        const bf16_t* Wg = (l ? p.Wsm1 : p.Wsm0) + OFF_WG;
        for (int c = tid; c < 2 * 88 * 12; c += 512) { const int gsel = c / (88 * 12), r = (c / 12) % 88, k8 = c % 12;
            *(u32x4*)(wg + (gsel * 88 + r) * RL_WSTR + k8 * 8) = *(const u32x4*)(Wg + (((size_t)gsel * 16 + n) * 96 + r) * 96 + k8 * 8); }
        if (tid < 96) { const int gc = l * DR + n * 88 + tid; const bool ok = tid < 88;
            cst[tid] = ok ? p.b_rg[gc] : 0.f; cst[96 + tid] = ok ? p.b_ig[gc] : 0.f; cst[192 + tid] = ok ? log1pf(__expf(-p.lam[gc])) : 0.f; }
        if (tid >= 128 && tid < 128 + 88) { const int c = tid - 128; const float* cw = p.conv_w + (size_t)l * 4 * DR + n * 88 + c;
            cst[288 + c] = cw[0]; cst[288 + 88 + c] = cw[DR]; cst[288 + 176 + c] = cw[2 * DR]; cst[288 + 264 + c] = cw[3 * DR]; cst[288 + 352 + c] = p.conv_b[(size_t)l * DR + n * 88 + c]; }
        if (tid >= 256 && tid < 256 + 88) car[tid - 256] = (f32x2){1.f, 0.f};
        if (tid >= 384 && tid < 384 + 33) { const int c = tid - 384, r = c / 11, cc = c - r * 11;
            f32x4 a0 = {0.f, 0.f, 0.f, 0.f}, a1 = a0;
            if (q > 0) load8f(p.halo + ((size_t)(b * 4 + q - 1) * 3 + r) * DR + n * 88 + cc * 8, a0, a1);
            *(f32x4*)(halo + r * 88 + cc * 8) = a0; *(f32x4*)(halo + r * 88 + cc * 8 + 4) = a1; }
    }
    __syncthreads();
    const float cw0 = cst[288 + sc_], cw1 = cst[288 + 88 + sc_], cw2 = cst[288 + 176 + sc_], cw3 = cst[288 + 264 + sc_], cbv = cst[288 + 352 + sc_];
    u32x4 xw[3], gw[3], xwn[3];
#define RNN_LOADX(dst, tk) do { _Pragma("unroll") for (int i = 0; i < 3; ++i) { const int c = tid + 512 * i, r = c / 11, cc = c - r * 11; \
            dst[i] = (u32x4){0u, 0u, 0u, 0u}; if (c < 128 * 11) dst[i] = *(const u32x4*)(p.xr + ((tk) + r) * DR + n * 88 + cc * 8); } } while (0)
    RNN_LOADX(xw, (size_t)b * S + q * 1024);
#pragma unroll 1
    for (int jc = 0; jc < 8; ++jc) {
        const int t0 = q * 1024 + jc * 128; const size_t tok0 = (size_t)b * S + t0;
#pragma unroll
        for (int i = 0; i < 3; ++i) { const int c = tid + 512 * i, r = c / 11, cc = c - r * 11;
            gw[i] = (u32x4){0u, 0u, 0u, 0u};
            if (c < 128 * 11) gw[i] = *(const u32x4*)(p.sgr + (tok0 + r) * DR + n * 88 + cc * 8); }
        if (tid < 264) xin[tid] = halo[tid];
#pragma unroll
        for (int i = 0; i < 3; ++i) { const int c = tid + 512 * i;
            if (c < 128 * 11) { const u32x4 w = xw[i]; float* d = xin + 264 + c * 8;
                *(f32x4*)d = (f32x4){bf_lo(w.x), bf_hi(w.x), bf_lo(w.y), bf_hi(w.y)}; *(f32x4*)(d + 4) = (f32x4){bf_lo(w.z), bf_hi(w.z), bf_lo(w.w), bf_hi(w.w)}; } }
        __syncthreads();
        if (jc < 7) RNN_LOADX(xwn, tok0 + 128);
        if (tid < 264) halo[tid] = xin[128 * 88 + tid];
        if (tid < 440) {
            const int tb0 = sg * 26;
            float x0 = xin[tb0 * 88 + sc_], x1 = xin[(tb0 + 1) * 88 + sc_], x2 = xin[(tb0 + 2) * 88 + sc_];
#pragma unroll
            for (int tt = 0; tt < 26; tt += 13) {
                float xn[13];
#pragma unroll
                for (int e = 0; e < 13; ++e) { const int t = tb0 + tt + e; xn[e] = (t < 128) ? xin[(t + 3) * 88 + sc_] : 0.f; }
#pragma unroll
                for (int e = 0; e < 13; ++e) { const int t = tb0 + tt + e;
                    const float vv = cbv + cw0 * x0 + cw1 * x1 + cw2 * x2 + cw3 * xn[e];
                    if (t < 128) { xcu[t * 88 + sc_] = vv; xa[t * 96 + sc_] = f2bf(vv); }
                    x0 = x1; x1 = x2; x2 = xn[e]; }
            }
        } else { for (int e = tid - 440; e < 128 * 8; e += 72) xa[(e >> 3) * 96 + 88 + (e & 7)] = 0; }
        __syncthreads();
        f32x2* wagg = (f32x2*)(smem + RL_XA);
        f32x2* wcar = wagg + 8 * 88;
        float* aout = xin;
        {
            bf16x8 a[3];
#pragma unroll
            for (int s3 = 0; s3 < 3; ++s3) a[s3] = *(const bf16x8*)(xa + (wid * 16 + fr) * 96 + s3 * 32 + fq * 8);
            __syncthreads();
#pragma unroll
            for (int nt = 0; nt < 6; ++nt) {
                f32x4 accr = {0.f, 0.f, 0.f, 0.f}, acci = accr;
                const bf16_t* wr_ = wg + (nt * 16 + fr) * RL_WSTR + fq * 8; const bf16_t* wi_ = wr_ + 88 * RL_WSTR;
#pragma unroll
                for (int s3 = 0; s3 < 3; ++s3) {
                    accr = __builtin_amdgcn_mfma_f32_16x16x32_bf16(a[s3], *(const bf16x8*)(wr_ + s3 * 32), accr, 0, 0, 0);
                    acci = __builtin_amdgcn_mfma_f32_16x16x32_bf16(a[s3], *(const bf16x8*)(wi_ + s3 * 32), acci, 0, 0, 0);
                }
                const int c = nt * 16 + fr; const bool okc = c < 88; const int cs = okc ? c : 87;
                const float brg = cst[cs], big = cst[96 + cs], sp = cst[192 + cs];
                float Pl[4], hl[4];
                { float P = 1.f, h = 0.f;
#pragma unroll
                  for (int r = 0; r < 4; ++r) {
                      const int t = wid * 16 + fq * 4 + r;
                      const float rg = sigmoidf_(accr[r] + brg), ig = sigmoidf_(acci[r] + big);
                      const float la = -8.0f * rg * sp, av = __expf(la), mult = __builtin_amdgcn_sqrtf(-expm1_small(2.0f * la));
                      const float uv = mult * ig * xcu[t * 88 + cs];
                      h = av * h + uv; P *= av; Pl[r] = P; hl[r] = h; } }
                float Pg = Pl[3], hg = hl[3];
                { const float Pp = __shfl_up(Pg, 16), hp = __shfl_up(hg, 16); if (fq >= 1) { hg = Pg * hp + hg; Pg = Pp * Pg; } }
                { const float Pp = __shfl_up(Pg, 32), hp = __shfl_up(hg, 32); if (fq >= 2) { hg = Pg * hp + hg; Pg = Pp * Pg; } }
                float Pe = __shfl_up(Pg, 16), he = __shfl_up(hg, 16); if (fq == 0) { Pe = 1.f; he = 0.f; }
                if (okc) {
#pragma unroll
                    for (int r = 0; r < 4; ++r) { const int t = wid * 16 + fq * 4 + r; aout[t * 88 + c] = Pe * Pl[r]; xcu[t * 88 + c] = Pl[r] * he + hl[r]; }
                    if (fq == 3) wagg[wid * 88 + c] = (f32x2){Pg, hg};
                }
            }
        }
        __syncthreads();
        if (tid < 88) {
            f32x2 cr = car[(jc & 1) * 88 + tid]; float P = cr[0], h = cr[1];
#pragma unroll
            for (int w8 = 0; w8 < 8; ++w8) { wcar[w8 * 88 + tid] = (f32x2){P, h}; const f32x2 gq = wagg[w8 * 88 + tid]; h = gq[0] * h + gq[1]; P *= gq[0]; }
            car[((jc + 1) & 1) * 88 + tid] = (f32x2){P, h};
        }
        __syncthreads();
#pragma unroll
        for (int i = 0; i < 3; ++i) { const int c = tid + 512 * i, r = c / 11, cc = c - r * 11;
            if (c < 128 * 11) {
                const u32x4 w = gw[i];
                const f32x4 g0 = {bf_lo(w.x), bf_hi(w.x), bf_lo(w.y), bf_hi(w.y)}, g1 = {bf_lo(w.z), bf_hi(w.z), bf_lo(w.w), bf_hi(w.w)};
                const float* hp = xcu + c * 8; const float* pp = aout + c * 8;
                const f32x2* wcp = wcar + (r >> 4) * 88 + cc * 8;
                f32x4 cP0, cP1, cH0, cH1;
#pragma unroll
                for (int e = 0; e < 4; ++e) { const f32x2 w0 = wcp[e], w1 = wcp[4 + e]; cP0[e] = w0[0]; cH0[e] = w0[1]; cP1[e] = w1[0]; cH1[e] = w1[1]; }
                const f32x4 pl0 = *(const f32x4*)pp, pl1 = *(const f32x4*)(pp + 4);
                const f32x4 hh0 = *(const f32x4*)hp + pl0 * cH0, hh1 = *(const f32x4*)(hp + 4) + pl1 * cH1;
                if (!dry) store8(p.sgr + (tok0 + r) * DR + n * 88 + cc * 8, g0 * hh0, g1 * hh1);
                if (q > 0 && !dry) store8(p.xr + (tok0 + r) * DR + n * 88 + cc * 8, g0 * (pl0 * cP0), g1 * (pl1 * cP1));
            } }
#pragma unroll
        for (int i = 0; i < 3; ++i) xw[i] = xwn[i];
        __syncthreads();
    }
#undef RNN_LOADX
    if (tid < 88) *(f32x2*)(p.agg + (((size_t)b * 4 + q) * DR + n * 88 + tid) * 2) = car[tid];
    __syncthreads();
}
DEVI void rnn_fix(const Params& p, int task, unsigned char* smem) {
    const int tid = otid();
    const int sidx = task >> 2, sub = task & 3;
    const int b = sidx / 48, rem = sidx - b * 48, q = 1 + rem / 16, n = rem & 15;
    float* Cq = (float*)smem;
    if (tid < 88) { float h = 0.f;
        for (int qq = 0; qq < q; ++qq) { const f32x2 gq = *(const f32x2*)(p.agg + (((size_t)b * 4 + qq) * DR + n * 88 + tid) * 2); h = gq[0] * h + gq[1]; }
        Cq[tid] = h; }
    __syncthreads();
    const size_t tok0 = (size_t)b * S + q * 1024 + sub * 256;
    u32x4 hv[6], sv[6];
#pragma unroll
    for (int i = 0; i < 6; ++i) { const int c = tid + 512 * i, r = c / 11, cc = c - r * 11;
        if (c < 256 * 11) { hv[i] = *(const u32x4*)(p.sgr + (tok0 + r) * DR + n * 88 + cc * 8); sv[i] = *(const u32x4*)(p.xr + (tok0 + r) * DR + n * 88 + cc * 8); } }
#pragma unroll
    for (int i = 0; i < 6; ++i) { const int c = tid + 512 * i, r = c / 11, cc = c - r * 11;
        if (c < 256 * 11) {
            const u32x4 hw = hv[i], sw = sv[i];
            const f32x4 h0 = {bf_lo(hw.x), bf_hi(hw.x), bf_lo(hw.y), bf_hi(hw.y)}, h1 = {bf_lo(hw.z), bf_hi(hw.z), bf_lo(hw.w), bf_hi(hw.w)};
            const f32x4 s0 = {bf_lo(sw.x), bf_hi(sw.x), bf_lo(sw.y), bf_hi(sw.y)}, s1 = {bf_lo(sw.z), bf_hi(sw.z), bf_lo(sw.w), bf_hi(sw.w)};
            const f32x4 c0 = *(const f32x4*)(Cq + cc * 8), c1 = *(const f32x4*)(Cq + cc * 8 + 4);
            store8(p.sgr + (tok0 + r) * DR + n * 88 + cc * 8, h0 + s0 * c0, h1 + s1 * c1); } }
    __syncthreads();
}

DEVI void phase_prep_rows(const Params& p) {
    const int tid_ = otid(), wid = tid_ >> 6, lane = tid_ & 63;
    for (int row = blockIdx.x * 8 + wid; row < T; row += gridDim.x * 8) {
        const f32x4* xp = (const f32x4*)(p.x + (size_t)row * 1024);
        float s = 0.f;
#pragma unroll
        for (int i = 0; i < 4; ++i) { const f32x4 vv = __builtin_nontemporal_load(xp + i * 64 + lane); s += (vv[0] * vv[0] + vv[1] * vv[1]) + (vv[2] * vv[2] + vv[3] * vv[3]);
            u32x2 w; w.x = cvtpk(vv[0], vv[1]); w.y = cvtpk(vv[2], vv[3]); *(u32x2*)(p.xb + (size_t)row * 1024 + (i * 64 + lane) * 4) = w; }
        s = wave_sum(s);
        if (lane < 16) p.ssq[(size_t)row * 16 + lane] = (lane == 0) ? s : 0.f;
    }
}
DEVI int win_src_col(int np) {
    const int pn = np >> 8, pp = np & 255, bj = pp >> 7, o = pp & 127;
    if (pn < 8) { const int hsel = o >> 6, i = o & 63; return (pn >= 4 ? 1024 : 0) + (2 * (pn & 3) + hsel) * 128 + bj * 64 + i; }
    if (pn < 12) return 2048 + (pn - 8) * 256 + pp;
    if (pn < 16) { const int hsel = o >> 5, i = o & 31; return 4096 + (4 * (pn - 12) + hsel) * 64 + bj * 32 + i; }
    if (pn < 27) return 5200 + (pn - 16) * 256 + pp;
    if (pn == 27) { if (bj == 0) { if (o < 32) return 5120 + o; if (o < 48) return 5184 + (o - 32); return -1; } else { if (o < 32) return 5152 + o; return -1; } }
    if (pn < 32) return 3072 + (pn - 28) * 256 + pp;
    if (pn < 36) return 8016 + (pn - 32) * 256 + pp;
    return 9040 + (pn - 36) * 256 + pp;
}
template <bool SCALE, bool WINMAP>
DEVI void conv_tile(const float* src, int ldsrc, int K, const float* scale, bf16_t* dst, int n0, int k0, unsigned char* smem) {
    float* tile = (float*)smem;
    const int tid = otid(), w = tid >> 6, lane = tid & 63;
    const int sc = WINMAP ? win_src_col(n0 + lane) : (n0 + lane);
    const int scs = sc < 0 ? 0 : sc; const float msk = sc < 0 ? 0.f : 1.f;
    float vv[8], gg[8];
#pragma unroll
    for (int r = 0; r < 8; ++r) { vv[r] = __builtin_nontemporal_load(src + (size_t)(k0 + w * 8 + r) * ldsrc + scs); gg[r] = SCALE ? scale[k0 + w * 8 + r] : 1.f; }
#pragma unroll
    for (int r = 0; r < 8; ++r) tile[(w * 8 + r) * 65 + lane] = vv[r] * gg[r] * msk;
    __syncthreads();
    { const int nn = tid >> 3, k8 = (tid & 7) * 8; f32x4 a0, a1;
#pragma unroll
      for (int e = 0; e < 4; ++e) { a0[e] = tile[(k8 + e) * 65 + nn]; a1[e] = tile[(k8 + 4 + e) * 65 + nn]; }
      store8(dst + (size_t)(n0 + nn) * K + k0 + k8, a0, a1); }
    __syncthreads();
}
DEVI void convert_big(const Params& p, int l, unsigned char* smem, int first, int stride) {
    const float* src = p.w_in + (size_t)l * 1024 * NIN; const float* g = p.norm_g + (size_t)l * 1024;
    for (int i = first; i < 160 * 16; i += stride) conv_tile<true, true>(src, NIN, 1024, g, p.WinT, (i >> 4) * 64, (i & 15) * 64, smem);
}
DEVI void convert_small(const Params& p, int l, unsigned char* smem, int first, int stride) {
    bf16_t* W = l ? p.Wsm1 : p.Wsm0;
    for (int i = first; i < 256 + 352 + 256; i += stride) {
        if (i < 256) conv_tile<false, false>(p.w_oa + (size_t)l * 1024 * 1024, 1024, 1024, nullptr, W + OFF_WA, (i >> 4) * 64, (i & 15) * 64, smem);
        else if (i < 608) { const int ii = i - 256; conv_tile<false, false>(p.w_or + (size_t)l * DR * 1024, 1024, DR, nullptr, W + OFF_WB, (ii / 22) * 64, (ii % 22) * 64, smem); }
        else { const int ii = i - 608; conv_tile<false, false>(p.w_o + (size_t)l * 1024 * 1024, 1024, 1024, nullptr, W + OFF_WO, (ii >> 4) * 64, (ii & 15) * 64, smem); }
    }
    for (int e = first * 512 + otid(); e < 2 * 16 * 96 * 96; e += stride * 512) {
        const int k = e % 96, nn = (e / 96) % 96, blk = (e / 9216) % 16, gsel = e / (9216 * 16);
        float vv = 0.f;
        if (k < 88 && nn < 88) vv = (gsel ? p.w_ig : p.w_rg)[(((size_t)l * 16 + blk) * 88 + k) * 88 + nn];
        W[OFF_WG + e] = f2bf(vv);
    }
}
DEVI void phase_final(const Params& p) {
    const int tid_ = otid(), wid = tid_ >> 6, lane = tid_ & 63;
    for (int row = blockIdx.x * 8 + wid; row < T; row += gridDim.x * 8) {
        const float rs = row_rstd(p.ssq, row);
        f32x4* xp = (f32x4*)(p.out + (size_t)row * 1024); const f32x4* gp = (const f32x4*)p.fin_g;
#pragma unroll
        for (int i = 0; i < 4; ++i) { const f32x4 vv = xp[i * 64 + lane], gg = gp[i * 64 + lane]; __builtin_nontemporal_store(vv * rs * gg, xp + i * 64 + lane); }
    }
}


#define XB_TMO      128
#define XB_XCNT(j)  (256  + 64 * (j))
#define XB_XSUB(j)  (1280 + 64 * (j))
#define XB_XGEN(j)  (2304 + 64 * (j))
#define XB_TOP      3328
#define XB_TOPGEN   3392
#define XCD_BAR_WORDS 3456
#define XB_SPIN_CAP (1u << 18)
DEVI unsigned xb_ld(unsigned* p)              { return __hip_atomic_load(p, __ATOMIC_RELAXED, __HIP_MEMORY_SCOPE_AGENT); }
DEVI unsigned xb_add(unsigned* p, unsigned v) { return __hip_atomic_fetch_add(p, v, __ATOMIC_RELAXED, __HIP_MEMORY_SCOPE_AGENT); }
DEVI unsigned xb_xcc_id() { return (unsigned)__builtin_amdgcn_s_getreg((3 << 11) | 20) & 0xFu; }
#define XB_SPIN(cond, bar) do { unsigned _sp = 0; while (cond) { __builtin_amdgcn_s_sleep(1); \
    if ((++_sp & 255u) == 0u) { if (xb_ld(&(bar)[XB_TMO])) break; if (_sp > XB_SPIN_CAP) { atomicAdd(&(bar)[XB_TMO], 1u); break; } } } } while (0)
struct XcdBarrier { unsigned* bar; unsigned x; volatile LAS unsigned* st; };
DEVI XcdBarrier xcd_barrier_post(unsigned* bar, volatile LAS unsigned* st) {
    XcdBarrier b; b.bar = bar; b.x = xb_xcc_id(); b.st = st;
    if (threadIdx.x == 0) (void)xb_add(&bar[XB_XCNT(b.x)], 1u);
    return b;
}
DEVI void xcd_barrier_complete(unsigned* bar, unsigned x, unsigned& nloc, unsigned& nx) {
    const unsigned G = gridDim.x * gridDim.y * gridDim.z;
    unsigned sum, cnt, mine, sp = 0u;
    for (;;) {
        sum = 0u; cnt = 0u; mine = 0u;
#pragma unroll
        for (unsigned j = 0; j < 16; ++j) { const unsigned c = xb_ld(&bar[XB_XCNT(j)]); sum += c; cnt += (c > 0u) ? 1u : 0u; mine = (j == x) ? c : mine; }
        if (sum == G) break;
        __builtin_amdgcn_s_sleep(1);
        if ((++sp & 255u) == 0u) { if (xb_ld(&bar[XB_TMO])) break; if (sp > XB_SPIN_CAP) { atomicAdd(&bar[XB_TMO], 1u); break; } }
    }
    nloc = mine > 0u ? mine : 1u; nx = cnt > 0u ? cnt : 1u;
}
DEVI void xcd_barrier(const XcdBarrier& b) {
    asm volatile("s_waitcnt vmcnt(0)" ::: "memory");
    __syncthreads();
    if (threadIdx.x == 0) {
        unsigned* bar = b.bar;
        __builtin_amdgcn_s_waitcnt(0);
        unsigned nloc = b.st[0], nx = b.st[1];
        if (nloc == 0u) { xcd_barrier_complete(bar, b.x, nloc, nx); b.st[0] = nloc; b.st[1] = nx; }
        const unsigned old = xb_add(&bar[XB_XSUB(b.x)], 1u);
        const unsigned gen = old / nloc;
        if (old + 1u == (gen + 1u) * nloc) {
            __builtin_amdgcn_fence(__ATOMIC_RELEASE, "agent");
            asm volatile("s_waitcnt vmcnt(0)" ::: "memory");
            const unsigned og = xb_add(&bar[XB_TOP], 1u);
            const unsigned tg = og / nx;
            if (og + 1u == (tg + 1u) * nx) xb_add(&bar[XB_TOPGEN], 1u);
            else XB_SPIN(xb_ld(&bar[XB_TOPGEN]) == tg, bar);
            __builtin_amdgcn_fence(__ATOMIC_ACQUIRE, "agent");
            xb_add(&bar[XB_XGEN(b.x)], 1u);
            asm volatile("s_waitcnt vmcnt(0)" ::: "memory");
        } else {
            XB_SPIN(xb_ld(&bar[XB_XGEN(b.x)]) == gen, bar);
            __builtin_amdgcn_fence(__ATOMIC_ACQUIRE, "agent");
            asm volatile("s_waitcnt vmcnt(0)" ::: "memory");
        }
    }
    __syncthreads();
}

DEVI void run_phase(const Params& p, int ph, unsigned char* smem) {
    LAS unsigned char* lds = (LAS unsigned char*)smem;
    const int G = gridDim.x, c = blockIdx.x;
    if (ph == 0) {
        phase_prep_rows(p);
        for (int rep = 0; rep < 1 + (PROBE_REP == 5); ++rep)
        convert_big(p, 0, smem, c, G);
        convert_small(p, 0, smem, c, G);
        return;
    }
    if (ph == NPH - 1) { phase_final(p); return; }
    const int l = (ph - 1) / 6, kind = (ph - 1) % 6;
    const bf16_t* Wsm = l ? p.Wsm1 : p.Wsm0;
    bf16_t* sma = p.iq; bf16_t* smb = p.xr; bf16_t* yag = p.k; bf16_t* merged = p.v; bf16_t* ag = p.q; bf16_t* hg = p.sgr;
    pg8::StaticOrder so;
    if (kind == 0) {
        pg8::Gemm g{p.xb, p.WinT, T, 28 * 256, 1024}; so.init(g.M, g.N, G, c);
        fill_rstd(p.ssq, p.pos, so, smem);
        EpiPA1 e{(const float*)(smem + RS_OFF), p.pos, p.q, p.k, p.v, p.iq, p.ik, p.xr, p.sgr, p.iw, p.halo};
        if (PROBE_REP == 11) { EpiTriv et{p.v}; pg8::gemm_phase(lds, g, so, et); }
        for (int rep = 0; rep < 1 + (PROBE_REP == 3); ++rep)
        pg8::gemm_phase(lds, g, so, e);
    } else if (kind == 1) {
#ifndef SKIP_IDX
        { IdxPre R; idx_issue(p, c, R);
          for (int u = c; u < 2048; u += G) idx_unit(p, u, (u + G < 2048) ? u + G : -1, R, smem); }
#endif
        if (PROBE_REP == 2) { for (int sq = c; sq < 256; sq += G) rnn_quarter(p, l, sq, smem, true); }
        for (int sq = c; sq < 256; sq += G) rnn_quarter(p, l, sq, smem, false);
    } else if (kind == 2) {
#ifndef SKIP_ATT
        if (PROBE_REP == 4) phase_attention(p, smem, p.iq);
        phase_attention(p, smem, p.q);
#endif
        for (int tk = c; tk < 768; tk += G) rnn_fix(p, tk, smem);
        if (l == 0) convert_small(p, 1, smem, c, G);
    } else if (kind == 3) {
        pg8::Gemm g{p.xb, p.WinT + (size_t)28 * 256 * 1024, T, 12 * 256, 1024}; so.init(g.M, g.N, G, c);
        fill_rstd(p.ssq, p.pos, so, smem);
        EpiPA2 e{(const float*)(smem + RS_OFF), ag, sma, smb};
        pg8::gemm_phase(lds, g, so, e);
    } else if (kind == 4) {
        for (int rep = 0; rep < 1 + (PROBE_REP == 6); ++rep) {
        { pg8::Gemm g{ag, Wsm + OFF_WA, T, 1024, 1024}; so.init(g.M, g.N, G, c);
          EpiPD<0> e{sma, nullptr, yag}; pg8::gemm_phase(lds, g, so, e); }
        { pg8::Gemm g{hg, Wsm + OFF_WB, T, 1024, DR}; so.init(g.M, g.N, G, c);
          EpiPD<1> e{smb, yag, merged}; pg8::gemm_phase(lds, g, so, e); }
        }
        if (l == 0) convert_big(p, 1, smem, c, G);
    } else {
        pg8::Gemm g{merged, Wsm + OFF_WO, T, 1024, 1024}; so.init(g.M, g.N, G, c);
        EpiPE e{l == 0 ? p.x : p.out, p.out, p.xb, p.ssq};
        pg8::gemm_phase(lds, g, so, e);
    }
}

__global__ void __launch_bounds__(512, 2) hybrid_fwd(Params p, int ph_lo, int ph_hi) {
    extern __shared__ __attribute__((aligned(16))) unsigned char smem[];
    volatile LAS unsigned* st = (volatile LAS unsigned*)((LAS unsigned char*)smem + (LDS_BYTES - 16));
    if (threadIdx.x == 0) { st[0] = 0u; st[1] = 0u; }
    __syncthreads();
    const XcdBarrier bar = xcd_barrier_post(p.bar, st);
    if (ph_hi < 0) cg::this_grid().sync();
    if (PROBE_REP == 10) { for (int i = 0; i < 20; ++i) xcd_barrier(bar); }
    for (int ph = ph_lo; ph < ph_hi; ++ph) {
        if (ph > ph_lo) xcd_barrier(bar);
        run_phase(p, ph, smem);
    }
}

extern "C" void kernel_launch(void* const* d_in, const int* in_sizes, int n_in, void* d_out, int out_size, void* d_ws, size_t ws_size, hipStream_t stream) {
    static int grid = 0;
    size_t off = 0; auto take = [&](size_t bytes) { size_t o = off; off += (bytes + 255) & ~(size_t)255; return o; };
    const size_t o_WinT = take((size_t)10240 * 1024 * 2), o_W0 = take(WSM_ELEMS * 2), o_W1 = take(WSM_ELEMS * 2);
    const size_t o_xb = take((size_t)T * 1024 * 2), o_ssq = take((size_t)T * 16 * 4);
    const size_t o_q = take((size_t)T * 1024 * 2), o_k = take((size_t)T * 1024 * 2), o_v = take((size_t)T * 1024 * 2), o_iq = take((size_t)T * 1024 * 2);
    const size_t o_ik = take((size_t)T * 64 * 2), o_iw = take((size_t)T * 16 * 4);
    const size_t o_xr = take((size_t)T * DR * 2), o_sgr = take((size_t)T * DR * 2);
    const size_t o_bm = take((size_t)NB * 64 * S * 8), o_agg = take((size_t)NB * 32 * DR * 2 * 4), o_bar = take((size_t)XCD_BAR_WORDS * 4), o_halo = take((size_t)16 * 3 * DR * 2);
    if (grid == 0) {
        if (n_in != 15 || out_size != T * 1024 || ws_size < off) { fprintf(stderr, "kernel_launch: unexpected shapes / workspace (n_in %d out %d ws %zu need %zu)\n", n_in, out_size, ws_size, off); grid = -1; return; }
        int dev = 0, cus = 0, per_cu = 0;
        (void)hipGetDevice(&dev); (void)hipDeviceGetAttribute(&cus, hipDeviceAttributeMultiprocessorCount, dev);
        if (hipFuncSetAttribute((const void*)hybrid_fwd, hipFuncAttributeMaxDynamicSharedMemorySize, LDS_BYTES) != hipSuccess) { fprintf(stderr, "kernel_launch: hipFuncSetAttribute failed\n"); grid = -1; return; }
        if (hipOccupancyMaxActiveBlocksPerMultiprocessor(&per_cu, (const void*)hybrid_fwd, 512, LDS_BYTES) != hipSuccess || per_cu < 1) { fprintf(stderr, "kernel_launch: occupancy query failed (%d)\n", per_cu); per_cu = 1; }
        (void)hipGetLastError();
        grid = cus * 1;
        if (grid <= 0) grid = 256;
    }
    if (grid < 0) return;
    Params p{};
    p.x = (const float*)d_in[0]; p.pos = (const int*)d_in[1]; p.norm_g = (const float*)d_in[2]; p.w_in = (const float*)d_in[3];
    p.conv_w = (const float*)d_in[4]; p.conv_b = (const float*)d_in[5]; p.w_rg = (const float*)d_in[6]; p.b_rg = (const float*)d_in[7];
    p.w_ig = (const float*)d_in[8]; p.b_ig = (const float*)d_in[9]; p.lam = (const float*)d_in[10]; p.w_oa = (const float*)d_in[11];
    p.w_or = (const float*)d_in[12]; p.w_o = (const float*)d_in[13]; p.fin_g = (const float*)d_in[14];
    p.out = (float*)d_out;
    unsigned char* ws = (unsigned char*)d_ws;
    p.WinT = (bf16_t*)(ws + o_WinT); p.Wsm0 = (bf16_t*)(ws + o_W0); p.Wsm1 = (bf16_t*)(ws + o_W1);
    p.xb = (bf16_t*)(ws + o_xb); p.ssq = (float*)(ws + o_ssq); p.q = (bf16_t*)(ws + o_q); p.k = (bf16_t*)(ws + o_k); p.v = (bf16_t*)(ws + o_v);
    p.iq = (bf16_t*)(ws + o_iq); p.ik = (bf16_t*)(ws + o_ik); p.iw = (float*)(ws + o_iw); p.xr = (bf16_t*)(ws + o_xr); p.sgr = (bf16_t*)(ws + o_sgr);
    p.bm = (u64*)(ws + o_bm); p.agg = (float*)(ws + o_agg); p.bar = (unsigned*)(ws + o_bar); p.halo = (bf16_t*)(ws + o_halo);
    (void)hipMemsetAsync(ws + o_bar, 0, (size_t)XCD_BAR_WORDS * 4, stream);
#if N_LAUNCH_MODE == 1
    int lo = 0, hi = NPH; void* args[] = {&p, &lo, &hi};
    hipError_t e = hipLaunchCooperativeKernel((const void*)hybrid_fwd, dim3(grid), dim3(512), args, LDS_BYTES, stream);
    if (e != hipSuccess) fprintf(stderr, "cooperative launch failed: %s (grid %d)\n", hipGetErrorString(e), grid);
#else
    for (int ph = 0; ph < NPH; ++ph) hipLaunchKernelGGL(hybrid_fwd, dim3(grid), dim3(512), LDS_BYTES, stream, p, ph, ph + 1);
#endif
}
```

```cpp
#include <hip/hip_runtime.h>
#include <hip/hip_cooperative_groups.h>
#include <cstdio>
#include <cstdint>
namespace cg = cooperative_groups;

#ifndef N_LAUNCH_MODE
#define N_LAUNCH_MODE 1
#endif

#ifndef PROBE_REP
#define PROBE_REP 0
#endif
#define DEVI __device__ __forceinline__
#define LAS __attribute__((address_space(3)))
typedef unsigned short bf16_t;
typedef short bf16x8 __attribute__((ext_vector_type(8)));
typedef short s16x4 __attribute__((ext_vector_type(4)));
typedef float f32x2 __attribute__((ext_vector_type(2)));
typedef float f32x4 __attribute__((ext_vector_type(4)));
typedef float f32x16 __attribute__((ext_vector_type(16)));
typedef unsigned u32x2 __attribute__((ext_vector_type(2)));
typedef unsigned u32x4 __attribute__((ext_vector_type(4)));
typedef unsigned long long u64;

constexpr int T = 16384, S = 4096, NB = 4, DM = 1024, DR = 1408, NIN = 10064;
constexpr int LDS_BYTES = 160 * 1024;
constexpr int NPH = 14;

__device__ const float c_inv128[64] = {
1.0f,0.865964353f,0.749894202f,0.649381638f,0.562341332f,0.486967534f,0.421696514f,0.365174115f,0.316227764f,0.273841977f,0.237137377f,0.2053525f,0.177827939f,0.153992653f,0.133352146f,0.115478195f,0.100000001f,0.0865964293f,0.0749894232f,0.0649381652f,0.0562341325f,0.0486967526f,0.0421696492f,0.0365174115f,0.0316227749f,0.0273841955f,0.0237137377f,0.0205352511f,0.0177827943f,0.0153992651f,0.013335214f,0.0115478197f,0.00999999978f,0.00865964312f,0.00749894232f,0.00649381615f,0.00562341325f,0.00486967526f,0.00421696482f,0.00365174119f,0.00316227763f,0.00273841969f,0.00237137382f,0.00205352507f,0.00177827943f,0.00153992651f,0.00133352145f,0.00115478202f,0.00100000005f,0.000865964335f,0.000749894185f,0.000649381604f,0.000562341302f,0.000486967532f,0.000421696517f,0.000365174114f,0.000316227757f,0.000273841957f,0.00023713737f,0.00020535251f,0.00017782794f,0.00015399266f,0.00013335215f,0.0001154782f};

constexpr size_t OFF_WA = 0, OFF_WB = (size_t)1024 * 1024, OFF_WO = OFF_WB + (size_t)1024 * 1408, OFF_WG = OFF_WO + (size_t)1024 * 1024, WSM_ELEMS = OFF_WG + (size_t)2 * 16 * 96 * 96;

struct Params {
    const float* x; const int* pos; const float* norm_g; const float* w_in; const float* conv_w; const float* conv_b;
    const float* w_rg; const float* b_rg; const float* w_ig; const float* b_ig; const float* lam;
    const float* w_oa; const float* w_or; const float* w_o; const float* fin_g;
    float* out;
    bf16_t* WinT; bf16_t* Wsm0; bf16_t* Wsm1;
    bf16_t* xb; float* ssq; bf16_t* q; bf16_t* k; bf16_t* v; bf16_t* iq; bf16_t* ik; float* iw; bf16_t* xr; bf16_t* sgr;
    u64* bm; float* agg; unsigned* bar; bf16_t* halo;
};

DEVI unsigned cvtpk(float lo, float hi) { unsigned r; asm volatile("v_cvt_pk_bf16_f32 %0, %1, %2" : "=v"(r) : "v"(lo), "v"(hi)); return r; }
DEVI float bf_lo(unsigned w) { return __uint_as_float(w << 16); }
DEVI float bf_hi(unsigned w) { return __uint_as_float(w & 0xffff0000u); }
DEVI bf16_t f2bf(float f) { return (bf16_t)(cvtpk(f, 0.f) & 0xffffu); }
DEVI float sigmoidf_(float x) { return __builtin_amdgcn_rcpf(1.0f + __expf(-x)); }
DEVI float siluf_(float x) { return x * __builtin_amdgcn_rcpf(1.0f + __expf(-x)); }
DEVI float expm1_small(float x) {
    const float pl = x * (1.0f + x * (0.5f + x * (0.16666667f + x * (0.041666668f + x * 0.0083333338f))));
    float ex = __expf(x) - 1.0f;
    asm volatile("" : "+v"(ex));
    return fabsf(x) < 0.25f ? pl : ex;
}
DEVI int wave_sum_small(int v) {
    int t = 0;
#pragma unroll
    for (int b = 0; b < 7; ++b) t += __popcll(__ballot((v >> b) & 1)) << b;
    return t;
}
DEVI int otid() { int t = threadIdx.x; asm volatile("" : "+v"(t)); return t; }
DEVI float wave_sum(float s) {
#pragma unroll
    for (int o = 32; o > 0; o >>= 1) s += __shfl_xor(s, o);
    return s;
}
DEVI float row_rstd(const float* ssq, int row) {
    const f32x4* p = (const f32x4*)(ssq + (size_t)row * 16);
    const f32x4 a = p[0], b = p[1], c = p[2], d = p[3];
    const float s = ((a[0] + a[1]) + (a[2] + a[3])) + ((b[0] + b[1]) + (b[2] + b[3])) + ((c[0] + c[1]) + (c[2] + c[3])) + ((d[0] + d[1]) + (d[2] + d[3]));
    return rsqrtf(s * (1.0f / 1024.0f) + 1e-6f);
}

namespace pg8 {
constexpr int BM = 256, BK = 64, HALF = 128, HTB = HALF * BK * 2, STAGE_BYTES = 8 * HTB, NXCD = 8, WGM = 4;
DEVI int lds_byte(int r, int c) { const int st = (r >> 4) * 2 + (c >> 5), rr = r & 15, cc = c & 31, ob = rr * 64 + cc * 2; return st * 1024 + (ob ^ (((ob >> 9) & 1) << 5)); }
DEVI void stage_rc(int b, int& R, int& C) { const int st = b / 1024, sb = b % 1024, swz = sb ^ (((sb >> 9) & 1) << 5); R = (st >> 1) * 16 + swz / 64; C = (st & 1) * 32 + (swz % 64) / 2; }
DEVI int perm32(int rho) { const int n = rho >> 4, i = rho & 15; return 8 * (i >> 2) + 4 * n + (i & 3); }
struct Unit { int pm, pn; };
struct Gemm { const bf16_t* A; const bf16_t* Bt; int M, N, K; };
struct StaticOrder {
    int nM, nN, nwg, G, c;
    DEVI void init(int M, int N, int G_, int c_) { nM = M / BM; nN = N / BM; nwg = nM * nN; G = G_; c = c_; }
    DEVI bool next(int i, Unit& u) const {
        const long L = (long)i * G + c; if (L >= nwg) return false;
        int wgid = (int)L; { const int q = nwg / NXCD, r = nwg % NXCD, xcd = wgid % NXCD, off = wgid / NXCD; wgid = (xcd < r ? xcd * (q + 1) : r * (q + 1) + (xcd - r) * q) + off; }
        const int nig = WGM * nN, gid = wgid / nig, fm = gid * WGM, gsz = (nM - fm) < WGM ? (nM - fm) : WGM;
        u.pm = fm + ((wgid % nig) % gsz); u.pn = (wgid % nig) / gsz; return true;
    }
    DEVI void a_ready(const Unit&) const {}
    DEVI void done(const Unit&) const {}
};

template <class Epi, class Sched>
DEVI void gemm_phase(LAS unsigned char* lds, const Gemm g, const Sched& S, const Epi& E) {
    const int tid = otid(), wid = __builtin_amdgcn_readfirstlane(tid >> 6), lane = tid & 63, wr = wid >> 2, wc = wid & 3, fr = lane & 15, fq = lane >> 4;
    const int K = g.K, nt = K / BK;
    unsigned voffA[2], voffB[2];
#pragma unroll
    for (int i = 0; i < 2; ++i) { int R, C; stage_rc(tid * 16 + i * 8192, R, C); const int Rb = Epi::PERM ? ((R & ~31) + perm32(R & 31)) : R;
        voffA[i] = (unsigned)(R * K + C) * 2u; voffB[i] = (unsigned)(Rb * K + C) * 2u; }
    const size_t kstep = (size_t)(BK * 2);
    const size_t hstep = (size_t)HALF * K * 2;
    const size_t tstep = 2 * hstep;
    const unsigned ldsw = (unsigned)wid * 1024u;
    const int aoff = lds_byte(wr * 64 + fr, fq * 8), boff = lds_byte(wc * 32 + fr, fq * 8);
#define PG8_SA(b, h) (((b) * 2 + (h)) * HTB)
#define PG8_SB(b, h) ((4 + (b) * 2 + (h)) * HTB)
#define PG8_STAGE(bufoff, gbase, voff) do { _Pragma("unroll") for (int _i = 0; _i < 2; ++_i) \
        __builtin_amdgcn_global_load_lds((const unsigned*)((const char*)(gbase) + (voff)[_i]), (LAS unsigned*)(lds + (bufoff) + ldsw + _i * 8192), 16, 0, 0); } while (0)
#define PG8_LDA(dst, b, h) do { _Pragma("unroll") for (int m = 0; m < 4; ++m) _Pragma("unroll") for (int k = 0; k < 2; ++k) dst[m][k] = *(const LAS bf16x8*)(lds + PG8_SA(b, h) + aoff + m * 2048 + k * 1024); } while (0)
#define PG8_LDB(dst, b, h) do { _Pragma("unroll") for (int n = 0; n < 2; ++n) _Pragma("unroll") for (int k = 0; k < 2; ++k) dst[n][k] = *(const LAS bf16x8*)(lds + PG8_SB(b, h) + boff + n * 2048 + k * 1024); } while (0)
#define PG8_MMA(ai, bj, At, Bt) do { __builtin_amdgcn_s_setprio(1); _Pragma("unroll") for (int m = 0; m < 4; ++m) _Pragma("unroll") for (int n = 0; n < 2; ++n) _Pragma("unroll") for (int k = 0; k < 2; ++k) \
        acc[ai][bj][m][n] = __builtin_amdgcn_mfma_f32_16x16x32_bf16(Bt[n][k], At[m][k], acc[ai][bj][m][n], 0, 0, 0); __builtin_amdgcn_s_setprio(0); } while (0)
#define PG8_WAIT_V(n) asm volatile("s_waitcnt vmcnt(" #n ")" ::: "memory")
#define PG8_WAIT_L(n) asm volatile("s_waitcnt lgkmcnt(" #n ")" ::: "memory")
#define PG8_BAR __builtin_amdgcn_s_barrier()
#define PG8_SCHED __builtin_amdgcn_sched_barrier(0)
    Unit cur, nxt; int ui = 0;
    if (!S.next(0, cur)) return;
    f32x4 acc[2][2][4][2];
#pragma unroll
    for (int a = 0; a < 2; ++a)
#pragma unroll
        for (int b = 0; b < 2; ++b)
#pragma unroll
            for (int m = 0; m < 4; ++m)
#pragma unroll
                for (int n = 0; n < 2; ++n) acc[a][b][m][n] = (f32x4){0.f, 0.f, 0.f, 0.f};
    bf16x8 At[4][2], B0[2][2], B1[2][2];
    const char* cA = (const char*)g.A + (size_t)cur.pm * tstep; const char* cB = (const char*)g.Bt + (size_t)cur.pn * tstep;
    S.a_ready(cur);
    PG8_STAGE(PG8_SB(0, 0), cB, voffB); PG8_STAGE(PG8_SA(0, 0), cA, voffA); PG8_STAGE(PG8_SB(0, 1), cB + hstep, voffB); PG8_STAGE(PG8_SA(0, 1), cA + hstep, voffA);
    if (wr == 1) PG8_BAR;
    PG8_WAIT_V(4); PG8_BAR;
    PG8_STAGE(PG8_SB(1, 0), cB + kstep, voffB); PG8_STAGE(PG8_SA(1, 0), cA + kstep, voffA); PG8_STAGE(PG8_SB(1, 1), cB + hstep + kstep, voffB);
    PG8_WAIT_V(6); PG8_BAR;
    for (;;) {
        const bool has_next = S.next(ui + 1, nxt);
        const char* nA = has_next ? (const char*)g.A + (size_t)nxt.pm * tstep : cA; const char* nB = has_next ? (const char*)g.Bt + (size_t)nxt.pn * tstep : cB;
        for (int t = 0; t < nt; t += 2) {
            const bool last = (t == nt - 2);
            const char* a1 = cA + (size_t)(t + 1) * kstep;
            const char* a2 = last ? nA : cA + (size_t)(t + 2) * kstep; const char* b2 = last ? nB : cB + (size_t)(t + 2) * kstep;
            const char* a3 = a2 + kstep; const char* b3 = b2 + kstep;
            if (last && has_next) S.a_ready(nxt);
            PG8_LDB(B0, 0, 0); PG8_SCHED; PG8_LDA(At, 0, 0); PG8_STAGE(PG8_SA(1, 1), a1 + hstep, voffA);
            PG8_WAIT_L(8); PG8_BAR; PG8_WAIT_L(0); PG8_MMA(0, 0, At, B0); PG8_BAR; PG8_SCHED;
            PG8_LDB(B1, 0, 1); PG8_STAGE(PG8_SB(0, 0), b2, voffB);
            PG8_BAR; PG8_WAIT_L(0); PG8_MMA(0, 1, At, B1); PG8_BAR;
            PG8_LDA(At, 0, 1); PG8_STAGE(PG8_SA(0, 0), a2, voffA);
            PG8_BAR; PG8_WAIT_L(0); PG8_MMA(1, 0, At, B0); PG8_BAR; PG8_SCHED;
            PG8_STAGE(PG8_SB(0, 1), b2 + hstep, voffB);
            PG8_WAIT_V(6); PG8_BAR; PG8_MMA(1, 1, At, B1); PG8_BAR;
            PG8_LDB(B0, 1, 0); PG8_SCHED; PG8_LDA(At, 1, 0); PG8_STAGE(PG8_SA(0, 1), a2 + hstep, voffA);
            PG8_WAIT_L(8); PG8_BAR; PG8_WAIT_L(0); PG8_MMA(0, 0, At, B0); PG8_BAR; PG8_SCHED;
            PG8_LDB(B1, 1, 1); PG8_STAGE(PG8_SB(1, 0), b3, voffB);
            PG8_BAR; PG8_WAIT_L(0); PG8_MMA(0, 1, At, B1); PG8_BAR;
            PG8_LDA(At, 1, 1); PG8_STAGE(PG8_SA(1, 0), a3, voffA);
            PG8_BAR; PG8_WAIT_L(0); PG8_MMA(1, 0, At, B0); PG8_BAR; PG8_SCHED;
            PG8_STAGE(PG8_SB(1, 1), b3 + hstep, voffB);
            PG8_WAIT_V(6); PG8_BAR; PG8_MMA(1, 1, At, B1); PG8_BAR;
        }
        E(acc, cur, ui, wr, wc, fr, fq); S.done(cur);
        if (!has_next) break;
#pragma unroll
        for (int a = 0; a < 2; ++a)
#pragma unroll
            for (int b = 0; b < 2; ++b)
#pragma unroll
                for (int m = 0; m < 4; ++m)
#pragma unroll
                    for (int n = 0; n < 2; ++n) acc[a][b][m][n] = (f32x4){0.f, 0.f, 0.f, 0.f};
        cur = nxt; cA = nA; cB = nB; ++ui;
    }
    PG8_WAIT_V(0);
    if (wr == 0) PG8_BAR;
    PG8_BAR;
#undef PG8_SA
#undef PG8_SB
#undef PG8_STAGE
#undef PG8_LDA
#undef PG8_LDB
#undef PG8_MMA
#undef PG8_WAIT_V
#undef PG8_WAIT_L
#undef PG8_BAR
#undef PG8_SCHED
}
}
using pg8::Unit;

constexpr int RS_OFF = 131072;
template <class Sched> DEVI void fill_rstd(const float* ssq, const int* pos, const Sched& S, unsigned char* smem) {
    float* rs = (float*)(smem + RS_OFF);
    const int tid = otid(), w = tid >> 6, lane = tid & 63;
    Unit u;
    if (S.next(w, u)) {
#pragma unroll
        for (int rr = 0; rr < 4; rr += 2) {
            const int r0 = lane + 64 * rr, r1 = r0 + 64;
            const f32x4* s0 = (const f32x4*)(ssq + (size_t)(u.pm * 256 + r0) * 16); const f32x4* s1 = (const f32x4*)(ssq + (size_t)(u.pm * 256 + r1) * 16);
            const f32x4 a = s0[0], b = s0[1], c = s0[2], d = s0[3], e = s1[0], f = s1[1], g = s1[2], h = s1[3];
            const int p0 = pos[u.pm * 256 + r0], p1 = pos[u.pm * 256 + r1];
            const float sm0 = ((a[0] + a[1]) + (a[2] + a[3])) + ((b[0] + b[1]) + (b[2] + b[3])) + ((c[0] + c[1]) + (c[2] + c[3])) + ((d[0] + d[1]) + (d[2] + d[3]));
            const float sm1 = ((e[0] + e[1]) + (e[2] + e[3])) + ((f[0] + f[1]) + (f[2] + f[3])) + ((g[0] + g[1]) + (g[2] + g[3])) + ((h[0] + h[1]) + (h[2] + h[3]));
            rs[w * 256 + r0] = rsqrtf(sm0 * (1.0f / 1024.0f) + 1e-6f); rs[w * 256 + r1] = rsqrtf(sm1 * (1.0f / 1024.0f) + 1e-6f);
            rs[2048 + w * 256 + r0] = (float)p0; rs[2048 + w * 256 + r1] = (float)p1;
        }
    }
    __syncthreads();
}
DEVI void store8(bf16_t* p, const f32x4& a, const f32x4& b) { u32x4 w; w.x = cvtpk(a[0], a[1]); w.y = cvtpk(a[2], a[3]); w.z = cvtpk(b[0], b[1]); w.w = cvtpk(b[2], b[3]); *(u32x4*)p = w; }
DEVI void load8f(const bf16_t* p, f32x4& a, f32x4& b) { const u32x4 w = *(const u32x4*)p; a = (f32x4){bf_lo(w.x), bf_hi(w.x), bf_lo(w.y), bf_hi(w.y)}; b = (f32x4){bf_lo(w.z), bf_hi(w.z), bf_lo(w.w), bf_hi(w.w)}; }

struct EpiPA1 {
    static constexpr bool PERM = true;
    const float* rsl; const int* pos; bf16_t* q; bf16_t* k; bf16_t* v; bf16_t* iq; bf16_t* ik; bf16_t* xr; bf16_t* sgr; float* iw; bf16_t* halo;
    DEVI void operator()(const f32x4 (&acc)[2][2][4][2], const Unit& u, int ui, int wr, int wc, int fr, int fq) const {
        const int pn = u.pn, row0 = u.pm * 256 + wr * 64 + fr, o = wc * 32 + 8 * fq;
        const bool rope = (pn < 8) || (pn >= 12 && pn < 16) || (pn == 27);
        if (rope) {
            bf16_t* dst; int ld, c1, c2, fi, fs; bool act = true, isw = false;
            if (pn < 8) { const int hsel = o >> 6, i0 = o & 63, head = 2 * (pn & 3) + hsel; dst = pn < 4 ? q : k; ld = 1024; c1 = head * 128 + i0; c2 = c1 + 64; fi = i0; fs = 1; }
            else if (pn < 16) { const int hsel = o >> 5, i0 = o & 31, head = 4 * (pn - 12) + hsel; dst = iq; ld = 1024; c1 = head * 64 + i0; c2 = c1 + 32; fi = 2 * i0; fs = 2; }
            else { dst = ik; ld = 64; c1 = o & 31; c2 = c1 + 32; fi = 2 * (o & 31); fs = 2; act = (wc == 0); isw = (wc == 1 && fq < 2); }
            float inv[8];
#pragma unroll
            for (int e = 0; e < 8; ++e) inv[e] = c_inv128[(fi + fs * e) & 63] * 0.15915494309189535f;
#pragma unroll
            for (int ai = 0; ai < 2; ++ai)
#pragma unroll
                for (int m = 0; m < 4; ++m) {
                    const int row = row0 + ai * 128 + m * 16; const float rs = rsl[ui * 256 + (row & 255)];
                    if (act) {
                        const float ps = rsl[2048 + ui * 256 + (row & 255)];
                        f32x4 o1[2], o2[2];
#pragma unroll
                        for (int n = 0; n < 2; ++n)
#pragma unroll
                            for (int j = 0; j < 4; ++j) {
                                const float x1 = acc[ai][0][m][n][j] * rs, x2 = acc[ai][1][m][n][j] * rs;
                                const float rev = __builtin_amdgcn_fractf(ps * inv[4 * n + j]);
                                const float sn = __builtin_amdgcn_sinf(rev), cs = __builtin_amdgcn_cosf(rev);
                                o1[n][j] = x1 * cs - x2 * sn; o2[n][j] = x2 * cs + x1 * sn;
                            }
                        store8(dst + (size_t)row * ld + c1, o1[0], o1[1]); store8(dst + (size_t)row * ld + c2, o2[0], o2[1]);
                    } else if (isw) {
                        const float sc = rs * 0.03125f;
                        float* wp = iw + (size_t)row * 16 + 8 * fq;
                        *(f32x4*)wp = acc[ai][0][m][0] * sc; *(f32x4*)(wp + 4) = acc[ai][0][m][1] * sc;
                    }
                }
        } else {
#pragma unroll
            for (int ai = 0; ai < 2; ++ai)
#pragma unroll
                for (int m = 0; m < 4; ++m) {
                    const int row = row0 + ai * 128 + m * 16; const float rs = rsl[ui * 256 + (row & 255)];
#pragma unroll
                    for (int bj = 0; bj < 2; ++bj) {
                        f32x4 a0 = acc[ai][bj][m][0] * rs, a1 = acc[ai][bj][m][1] * rs;
                        if (pn < 12) { store8(v + (size_t)row * 1024 + (pn - 8) * 256 + bj * 128 + o, a0, a1); }
                        else { const int gc = (pn - 16) * 256 + bj * 128 + o;
                            if (gc < DR) { store8(xr + (size_t)row * DR + gc, a0, a1);
                                if ((row & 1023) >= 1021) store8(halo + ((size_t)(row >> 10) * 3 + ((row & 1023) - 1021)) * DR + gc, a0, a1); }
                            else {
#pragma unroll
                                for (int j = 0; j < 4; ++j) { a0[j] = siluf_(a0[j]); a1[j] = siluf_(a1[j]); }
                                store8(sgr + (size_t)row * DR + gc - DR, a0, a1); } }
                    }
                }
        }
    }
};
struct EpiTriv {
    static constexpr bool PERM = true;
    bf16_t* v;
    DEVI void operator()(const f32x4 (&acc)[2][2][4][2], const Unit& u, int ui, int wr, int wc, int fr, int fq) const {
        const int row0 = u.pm * 256 + wr * 64 + fr, o = wc * 32 + 8 * fq;
#pragma unroll
        for (int ai = 0; ai < 2; ++ai)
#pragma unroll
            for (int m = 0; m < 4; ++m) { const int row = row0 + ai * 128 + m * 16;
#pragma unroll
                for (int bj = 0; bj < 2; ++bj) store8(v + (size_t)row * 1024 + (u.pn & 3) * 256 + bj * 128 + o, acc[ai][bj][m][0], acc[ai][bj][m][1]); }
    }
};
struct EpiPA2 {
    static constexpr bool PERM = true;
    const float* rsl; bf16_t* ag; bf16_t* sma; bf16_t* smb;
    DEVI void operator()(const f32x4 (&acc)[2][2][4][2], const Unit& u, int ui, int wr, int wc, int fr, int fq) const {
        const int pn = u.pn, row0 = u.pm * 256 + wr * 64 + fr, o = wc * 32 + 8 * fq;
#pragma unroll
        for (int ai = 0; ai < 2; ++ai) {
            u32x4 gv[4][2];
            if (pn < 4) {
#pragma unroll
                for (int m = 0; m < 4; ++m)
#pragma unroll
                    for (int bj = 0; bj < 2; ++bj) gv[m][bj] = *(const u32x4*)(ag + (size_t)(row0 + ai * 128 + m * 16) * 1024 + (pn & 3) * 256 + bj * 128 + o);
            }
#pragma unroll
            for (int m = 0; m < 4; ++m) {
                const int row = row0 + ai * 128 + m * 16; const float rs = rsl[ui * 256 + (row & 255)];
#pragma unroll
                for (int bj = 0; bj < 2; ++bj) {
                    f32x4 a0 = acc[ai][bj][m][0] * rs, a1 = acc[ai][bj][m][1] * rs;
                    const size_t off = (size_t)row * 1024 + (pn & 3) * 256 + bj * 128 + o;
                    if (pn < 4) { const u32x4 w = gv[m][bj];
                        const f32x4 g0 = {bf_lo(w.x), bf_hi(w.x), bf_lo(w.y), bf_hi(w.y)}, g1 = {bf_lo(w.z), bf_hi(w.z), bf_lo(w.w), bf_hi(w.w)};
#pragma unroll
                        for (int j = 0; j < 4; ++j) { a0[j] = siluf_(a0[j]) * g0[j]; a1[j] = siluf_(a1[j]) * g1[j]; }
                        store8(ag + off, a0, a1); }
                    else {
#pragma unroll
                        for (int j = 0; j < 4; ++j) { a0[j] = sigmoidf_(a0[j]); a1[j] = sigmoidf_(a1[j]); }
                        store8((pn < 8 ? sma : smb) + off, a0, a1); }
                }
            }
        }
    }
};
template <int MODE> struct EpiPD {
    static constexpr bool PERM = true;
    const bf16_t* gate; const bf16_t* yin; bf16_t* outp;
    DEVI void operator()(const f32x4 (&acc)[2][2][4][2], const Unit& u, int ui, int wr, int wc, int fr, int fq) const {
        const int row0 = u.pm * 256 + wr * 64 + fr, o = wc * 32 + 8 * fq;
#pragma unroll
        for (int ai = 0; ai < 2; ++ai) {
            u32x4 gv[4][2], yv[4][2];
#pragma unroll
            for (int m = 0; m < 4; ++m)
#pragma unroll
                for (int bj = 0; bj < 2; ++bj) { const size_t off = (size_t)(row0 + ai * 128 + m * 16) * 1024 + u.pn * 256 + bj * 128 + o;
                    gv[m][bj] = *(const u32x4*)(gate + off); if (MODE == 1) yv[m][bj] = *(const u32x4*)(yin + off); }
#pragma unroll
            for (int m = 0; m < 4; ++m)
#pragma unroll
                for (int bj = 0; bj < 2; ++bj) {
                    const size_t off = (size_t)(row0 + ai * 128 + m * 16) * 1024 + u.pn * 256 + bj * 128 + o;
                    const u32x4 w = gv[m][bj];
                    const f32x4 g0 = {bf_lo(w.x), bf_hi(w.x), bf_lo(w.y), bf_hi(w.y)}, g1 = {bf_lo(w.z), bf_hi(w.z), bf_lo(w.w), bf_hi(w.w)};
                    f32x4 a0 = acc[ai][bj][m][0] * g0, a1 = acc[ai][bj][m][1] * g1;
                    if (MODE == 1) { const u32x4 y = yv[m][bj];
                        a0 += (f32x4){bf_lo(y.x), bf_hi(y.x), bf_lo(y.y), bf_hi(y.y)}; a1 += (f32x4){bf_lo(y.z), bf_hi(y.z), bf_lo(y.w), bf_hi(y.w)}; }
                    store8(outp + off, a0, a1);
                }
        }
    }
};
struct EpiPE {
    static constexpr bool PERM = false;
    const float* xin; float* xout; bf16_t* xb; float* ssq;
    DEVI void operator()(const f32x4 (&acc)[2][2][4][2], const Unit& u, int ui, int wr, int wc, int fr, int fq) const {
        const int row0 = u.pm * 256 + wr * 64 + fr, col0 = u.pn * 256 + wc * 32 + 4 * fq;
#pragma unroll
        for (int ai = 0; ai < 2; ++ai) {
            f32x4 xv[4][2][2];
#pragma unroll
            for (int m = 0; m < 4; ++m)
#pragma unroll
                for (int bj = 0; bj < 2; ++bj)
#pragma unroll
                    for (int n = 0; n < 2; ++n) xv[m][bj][n] = *(const f32x4*)(xin + (size_t)(row0 + ai * 128 + m * 16) * 1024 + col0 + bj * 128 + n * 16);
#pragma unroll
            for (int m = 0; m < 4; ++m) {
                const int row = row0 + ai * 128 + m * 16; float s = 0.f;
#pragma unroll
                for (int bj = 0; bj < 2; ++bj)
#pragma unroll
                    for (int n = 0; n < 2; ++n) {
                        const size_t off = (size_t)row * 1024 + col0 + bj * 128 + n * 16;
                        const f32x4 x2 = xv[m][bj][n] + acc[ai][bj][m][n];
                        *(f32x4*)(xout + off) = x2;
                        u32x2 w; w.x = cvtpk(x2[0], x2[1]); w.y = cvtpk(x2[2], x2[3]); *(u32x2*)(xb + off) = w;
                        s += (x2[0] * x2[0] + x2[1] * x2[1]) + (x2[2] * x2[2] + x2[3] * x2[3]);
                    }
                s += __shfl_xor(s, 16); s += __shfl_xor(s, 32);
                if (fq == 0) ssq[(size_t)row * 16 + u.pn * 4 + wc] = s;
            }
        }
    }
};

namespace at {
constexpr int D = 128, RS = 1024;
constexpr float SCALE = 0.08838834764831845f;
constexpr float THR = 8.f;
constexpr int NW = 8, QBLK = 32, KVBLK = 64, QB = NW * QBLK;
constexpr int SHM_V = KVBLK * D * 2, SHM_K = KVBLK * D * 2;
#define KSWZ(row, colB) ((row) * 256 + ((colB) ^ (((row) & 7) << 4)))
#define SBAR() __builtin_amdgcn_sched_barrier(0)
DEVI int v_st(int k, int c) { const int kk = (k & ~0xC) | ((k & 4) << 1) | ((k & 8) >> 1); return ((kk >> 3) * 4 + (c >> 5)) * 512 + ((kk & 7) * 32 + (c & 31)) * 2; }
DEVI int v_rd_base(int lane) { return ((lane & 3) << 3) | (((lane >> 2) & 3) << 6) | (((lane >> 4) & 1) << 5) | (((lane >> 5) & 1) << 8); }
constexpr int v_rd_off(int d0, int ks, int half) { return d0 * 512 + ks * 4096 + half * 2048; }
DEVI int crow(int r, int hi) { return (r & 3) + 8 * (r >> 2) + 4 * hi; }
DEVI bf16x8 load8(const bf16_t* p) { return *reinterpret_cast<const bf16x8*>(p); }
DEVI void mask_bits(f32x16& p0, f32x16& p1, u64 mw, int hi) {
    const float NEG = -__builtin_inff();
    const unsigned lo = (unsigned)mw >> (4 * hi), hh = (unsigned)(mw >> 32) >> (4 * hi);
#pragma unroll
    for (int r = 0; r < 16; ++r) {
        const int c = (r & 3) + 8 * (r >> 2);
        if (!((lo >> c) & 1u)) p0[r] = NEG;
        if (!((hh >> c) & 1u)) p1[r] = NEG;
    }
}
DEVI void partialSM(f32x16& p0, f32x16& p1, float& m_reg, float& mn, float& alpha) {
    float pmax = p0[0];
#pragma unroll
    for (int r = 1; r < 16; ++r) pmax = fmaxf(pmax, p0[r]);
#pragma unroll
    for (int r = 0; r < 16; ++r) pmax = fmaxf(pmax, p1[r]);
    { auto rr = __builtin_amdgcn_permlane32_swap(__float_as_uint(pmax), __float_as_uint(pmax), false, false);
      pmax = fmaxf(__uint_as_float(rr[0]), __uint_as_float(rr[1])); }
    constexpr float C2 = 1.4426950408889634f * SCALE;
    if (__builtin_expect(__all((pmax - m_reg) * SCALE <= THR), 1)) { mn = m_reg; alpha = 1.f; }
    else { mn = fmaxf(m_reg, pmax); alpha = __builtin_amdgcn_exp2f((m_reg - mn) * C2); m_reg = mn; }
    const float mnL = -mn * C2;
#pragma unroll
    for (int r = 0; r < 16; ++r) p0[r] = fmaf(p0[r], C2, mnL);
#pragma unroll
    for (int r = 0; r < 16; ++r) p1[r] = fmaf(p1[r], C2, mnL);
#pragma unroll
    for (int r = 0; r < 16; ++r) p0[r] = __builtin_amdgcn_exp2f(p0[r]);
}
DEVI void finishSM(f32x16& p0, f32x16& p1, float alpha, float& l_reg, bf16x8& pa0, bf16x8& pa1, bf16x8& pa2, bf16x8& pa3) {
#pragma unroll
    for (int r = 0; r < 16; ++r) p1[r] = __builtin_amdgcn_exp2f(p1[r]);
    float ps = 0;
#pragma unroll
    for (int r = 0; r < 16; ++r) ps += p0[r];
#pragma unroll
    for (int r = 0; r < 16; ++r) ps += p1[r];
    { auto rr = __builtin_amdgcn_permlane32_swap(__float_as_uint(ps), __float_as_uint(ps), false, false);
      ps = __uint_as_float(rr[0]) + __uint_as_float(rr[1]); }
    l_reg = l_reg * alpha + ps;
#define PK4(P, B_, OUT) do { unsigned a0 = cvtpk(P[B_+0], P[B_+1]), a1 = cvtpk(P[B_+2], P[B_+3]);                          \
        unsigned b0 = cvtpk(P[B_+4], P[B_+5]), b1 = cvtpk(P[B_+6], P[B_+7]);                                             \
        auto r0 = __builtin_amdgcn_permlane32_swap(a0, b0, false, false); auto r1 = __builtin_amdgcn_permlane32_swap(a1, b1, false, false); \
        u32x4 w = {r0[0], r1[0], r0[1], r1[1]}; OUT = *reinterpret_cast<bf16x8*>(&w); } while (0)
    PK4(p0, 0, pa0); PK4(p0, 8, pa1); PK4(p1, 0, pa2); PK4(p1, 8, pa3);
#undef PK4
}
template <int KB>
DEVI void qkt(f32x16& p0, f32x16& p1, const char* K_lds, int r32, int hi, const LAS unsigned char* qb) {
    p0 = f32x16{}; p1 = f32x16{};
    const char* kb[4];
#pragma unroll
    for (int dd = 0; dd < 4; ++dd) kb[dd] = K_lds + KB * SHM_K + KSWZ(r32, (dd * 16 + hi * 8) * 2);
#pragma unroll
    for (int d0 = 0; d0 < 8; ++d0) { const char* a = kb[d0 & 3] + (d0 >> 2) * 128;
        bf16x8 b0 = *reinterpret_cast<const bf16x8*>(a);
        bf16x8 b1 = *reinterpret_cast<const bf16x8*>(a + 32 * 256);
        const bf16x8 qf = *(const LAS bf16x8*)(qb + d0 * 1024);
        p0 = __builtin_amdgcn_mfma_f32_32x32x16_bf16(b0, qf, p0, 0, 0, 0);
        p1 = __builtin_amdgcn_mfma_f32_32x32x16_bf16(b1, qf, p1, 0, 0, 0); }
}
template <int VB>
DEVI void pv_tile(f32x16* o, int vb0, bf16x8 pa0, bf16x8 pa1, bf16x8 pa2, bf16x8 pa3) {
#define TRRD(dst, off) asm volatile("ds_read_b64_tr_b16 %0, %1 offset:%2" : "=&v"(dst) : "v"(vb0), "i"(off) : "memory")
#define PV_D0(d0) do { s16x4 l0, l1, l2, l3, h0, h1, h2, h3; constexpr int b_ = VB * SHM_V + v_rd_off(d0, 0, 0); \
        TRRD(l0, b_); TRRD(h0, b_ + 2048); TRRD(l1, b_ + 4096); TRRD(h1, b_ + 6144); TRRD(l2, b_ + 8192); TRRD(h2, b_ + 10240); TRRD(l3, b_ + 12288); TRRD(h3, b_ + 14336); \
        asm volatile("s_waitcnt lgkmcnt(0)" ::: "memory"); SBAR();   \
        o[d0] = __builtin_amdgcn_mfma_f32_32x32x16_bf16(pa0, (bf16x8){l0[0], l0[1], l0[2], l0[3], h0[0], h0[1], h0[2], h0[3]}, o[d0], 0, 0, 0);   \
        o[d0] = __builtin_amdgcn_mfma_f32_32x32x16_bf16(pa1, (bf16x8){l1[0], l1[1], l1[2], l1[3], h1[0], h1[1], h1[2], h1[3]}, o[d0], 0, 0, 0);   \
        o[d0] = __builtin_amdgcn_mfma_f32_32x32x16_bf16(pa2, (bf16x8){l2[0], l2[1], l2[2], l2[3], h2[0], h2[1], h2[2], h2[3]}, o[d0], 0, 0, 0);   \
        o[d0] = __builtin_amdgcn_mfma_f32_32x32x16_bf16(pa3, (bf16x8){l3[0], l3[1], l3[2], l3[3], h3[0], h3[1], h3[2], h3[3]}, o[d0], 0, 0, 0); } while (0)
    PV_D0(0); PV_D0(1); PV_D0(2); PV_D0(3);
#undef PV_D0
#undef TRRD
}
struct BlockRef { const bf16_t* Q; const bf16_t* K; const bf16_t* V; bf16_t* O; const u64* M; int P0; };
struct Stg { bf16x8 st_v0, st_v1, st_k0, st_k1; };
constexpr int MOFF = 2 * SHM_V + 2 * SHM_K + NW * 64 * 4, QOFF = MOFF + 4096;
#define ROW(p, k0, rr) ((p) + (size_t)((k0) + (rr)) * RS + sc)
#define VMW() asm volatile("s_waitcnt vmcnt(0)" ::: "memory")
#define VMWN(n) asm volatile("s_waitcnt vmcnt(%0)" :: "i"(n) : "memory")
#define SLOAD_H(Kp, Vp, k0) do { S.st_v0 = load8(ROW(Vp, k0, sr)); S.st_v1 = load8(ROW(Vp, k0, 32 + sr));              \
                         S.st_k0 = load8(ROW(Kp, k0, sr)); S.st_k1 = load8(ROW(Kp, k0, 32 + sr)); } while (0)
#define SWRITE_HK(bf) do { *(bf16x8*)(K_lds + (bf) * SHM_K + kws) = S.st_k0; *(bf16x8*)(K_lds + (bf) * SHM_K + kws + 32 * 256) = S.st_k1; } while (0)
#define SWRITE_HV(bf) do { *(bf16x8*)(V_lds + (bf) * SHM_V + vst0) = S.st_v0; *(bf16x8*)(V_lds + (bf) * SHM_V + vst1) = S.st_v1; } while (0)
#define SWRITE_H(bf) do { SWRITE_HV(bf); SWRITE_HK(bf); } while (0)
DEVI void attn_block(const BlockRef& cur, char* lds) {
    const int tid = otid(), wid = __builtin_amdgcn_readfirstlane(tid >> 6), lane = tid & 63, r32 = lane & 31, hi = lane >> 5;
    const int NT = (cur.P0 + QB - 1) / KVBLK + 1;
    char* V_lds = lds; char* K_lds = lds + 2 * SHM_V;
    float* ws = (float*)(lds + 2 * SHM_V + 2 * SHM_K) + wid * 64; float* li_l = ws, * al_l = ws + 32;
    float m_reg = -1e30f, l_reg = 0; f32x16 o[4] = {};
    const int sr = tid >> 4, sc = (tid & 15) * 8, vst0 = v_st(sr, sc), vst1 = v_st(32 + sr, sc), kws = KSWZ(sr, sc * 2);
    const int vb0 = (int)(uintptr_t)V_lds + v_rd_base(lane);
    const bf16_t* Kh = cur.K; const bf16_t* Vh = cur.V;
    const char* Mu = (const char*)(cur.M + cur.P0 + wid * QBLK);
    const unsigned lane4 = (unsigned)lane * 4u;
    LAS unsigned char* mlds = (LAS unsigned char*)(lds + MOFF) + wid * 256;
    LAS unsigned char* qb = (LAS unsigned char*)(lds + QOFF) + wid * 8192 + lane * 16;
    Stg S;
#define RESC(a) do { if (__any((a) < 1.f)) { if (hi == 0) al_l[r32] = (a); asm volatile("s_waitcnt lgkmcnt(0)" ::: "memory");              \
                     for (int d_ = 0; d_ < 4; ++d_) for (int r = 0; r < 16; ++r) o[d_][r] *= al_l[crow(r, hi)]; } } while (0)
#define KBASE(t) ((t) * KVBLK)
#define MLOAD(t) do { __builtin_amdgcn_global_load_lds((const unsigned*)(Mu + (size_t)(t) * 32768 + lane4), (LAS unsigned*)(mlds + ((t) & 1) * 2048), 4, 0, 0); } while (0)
#define MASKT(P0_, P1_, t) do { const u64 mw_ = *(const LAS u64*)(mlds + ((t) & 1) * 2048 + r32 * 8); mask_bits(P0_, P1_, mw_, hi); } while (0)
    f32x16 pA0, pA1, pB0, pB1; float mnA, mnB, alA, alB; bf16x8 pa0, pa1, pa2, pa3;
    {
#pragma unroll
        for (int d0 = 0; d0 < 8; ++d0) { const bf16x8 qf = load8(cur.Q + (size_t)(wid * QBLK + r32) * RS + d0 * 16 + hi * 8); *(LAS bf16x8*)(qb + d0 * 1024) = qf; }
        SLOAD_H(Kh, Vh, 0); VMW(); SWRITE_H(0);
    }
    MLOAD(0);
    SLOAD_H(Kh, Vh, KBASE(1));
    __syncthreads();
    SBAR(); qkt<0>(pA0, pA1, K_lds, r32, hi, qb);
    VMWN(4);
    MASKT(pA0, pA1, 0); partialSM(pA0, pA1, m_reg, mnA, alA);
    VMW(); SWRITE_H(1);
    __syncthreads();
#define HALF_STEP(PX0, PX1, mnX, alX, PY0, PY1, alY, t, KB, VB, SB) do {                                                      \
        MLOAD(t);                                                                                                             \
        SBAR(); qkt<KB>(PX0, PX1, K_lds, r32, hi, qb);                                                                       \
        finishSM(PY0, PY1, alY, l_reg, pa0, pa1, pa2, pa3); SBAR();                                                           \
        if ((t) + 1 < NT) { SLOAD_H(Kh, Vh, KBASE((t) + 1)); SBAR(); }                                                        \
        pv_tile<VB>(o, vb0, pa0, pa1, pa2, pa3);                                                                              \
        if ((t) + 1 < NT) VMWN(4); else VMW();                                                                                \
        MASKT(PX0, PX1, t); partialSM(PX0, PX1, m_reg, mnX, alX);                                                             \
        __syncthreads();                                                                                                      \
        if ((t) + 1 < NT) { VMW(); SWRITE_H(SB); }                                                                            \
        RESC(alX); __syncthreads(); } while (0)
    for (int t = 1; t + 1 < NT; t += 2) {
        HALF_STEP(pB0, pB1, mnB, alB, pA0, pA1, alA, t, 1, 0, 0);
        HALF_STEP(pA0, pA1, mnA, alA, pB0, pB1, alB, t + 1, 0, 1, 1);
    }
    const bool even = (NT & 1) == 0;
    if (even) { MLOAD(NT - 1); SBAR(); qkt<1>(pB0, pB1, K_lds, r32, hi, qb); SBAR(); }
    finishSM(pA0, pA1, alA, l_reg, pa0, pa1, pa2, pa3); SBAR();
    pv_tile<0>(o, vb0, pa0, pa1, pa2, pa3);
    if (even) { VMW(); MASKT(pB0, pB1, NT - 1); partialSM(pB0, pB1, m_reg, mnB, alB); __syncthreads(); RESC(alB);
        finishSM(pB0, pB1, alB, l_reg, pa0, pa1, pa2, pa3); SBAR(); pv_tile<1>(o, vb0, pa0, pa1, pa2, pa3); }
    SBAR();
    if (hi == 0) li_l[r32] = l_reg; asm volatile("s_waitcnt lgkmcnt(0)" ::: "memory");
    float rli[16];
#pragma unroll
    for (int r = 0; r < 16; ++r) rli[r] = __builtin_amdgcn_rcpf(li_l[crow(r, hi)]);
    bf16_t* Ow = cur.O + (size_t)(wid * QBLK) * RS;
#pragma unroll
    for (int r = 0; r < 16; ++r) { const int orow = crow(r, hi);
#pragma unroll
        for (int d0 = 0; d0 < 4; ++d0) { const float v = o[d0][r] * rli[r];
            const float vn = __shfl_xor(v, 1);
            if ((r32 & 1) == 0) *(unsigned*)(Ow + (size_t)orow * RS + d0 * 32 + r32) = cvtpk(v, vn); } }
    __syncthreads();
#undef RESC
#undef KBASE
#undef MLOAD
#undef MASKT
#undef HALF_STEP
}
#undef ROW
#undef VMW
#undef VMWN
#undef SLOAD_H
#undef SWRITE_HK
#undef SWRITE_HV
#undef SWRITE_H
}

DEVI at::BlockRef attn_ref(const Params& p, int bh, int qb, bf16_t* obase) {
    const int b = bh >> 3, h = bh & 7; at::BlockRef r;
    const size_t base = (size_t)b * S * 1024 + h * 128;
    r.Q = p.q + base + (size_t)qb * 256 * 1024; r.O = obase + base + (size_t)qb * 256 * 1024;
    r.K = p.k + base; r.V = p.v + base; r.M = p.bm + (size_t)b * 64 * S; r.P0 = qb * 256;
    return r;
}
DEVI void phase_attention(const Params& p, unsigned char* smem, bf16_t* obase) {
    const int total = 256, G = gridDim.x;
    for (int c = blockIdx.x; c < total; c += G) {
        const int L = (G == 256) ? ((c & 7) * 32 + (c >> 3)) : c;
        const int bh = L >> 3, x = L & 7;
        at::attn_block(attn_ref(p, bh, 15 - x, obase), (char*)smem);
        at::attn_block(attn_ref(p, bh, x, obase), (char*)smem);
    }
}

DEVI void idx_cnt8(int& cl, unsigned cand, unsigned k0, unsigned k1, unsigned k2, unsigned k3, unsigned k4, unsigned k5, unsigned k6, unsigned k7) {
    u64 m0, m1, m2, m3, m4, m5, m6, m7;
    asm volatile(
        "v_cmp_le_u32_e64 %[m0], %[c], %[k0]\n\tv_cmp_le_u32_e64 %[m1], %[c], %[k1]\n\tv_cmp_le_u32_e64 %[m2], %[c], %[k2]\n\tv_cmp_le_u32_e64 %[m3], %[c], %[k3]\n\t"
        "v_cmp_le_u32_e64 %[m4], %[c], %[k4]\n\tv_cmp_le_u32_e64 %[m5], %[c], %[k5]\n\tv_cmp_le_u32_e64 %[m6], %[c], %[k6]\n\tv_cmp_le_u32_e64 %[m7], %[c], %[k7]\n\t"
        "v_addc_co_u32_e64 %[cl], %[m0], 0, %[cl], %[m0]\n\tv_addc_co_u32_e64 %[cl], %[m1], 0, %[cl], %[m1]\n\tv_addc_co_u32_e64 %[cl], %[m2], 0, %[cl], %[m2]\n\tv_addc_co_u32_e64 %[cl], %[m3], 0, %[cl], %[m3]\n\t"
        "v_addc_co_u32_e64 %[cl], %[m4], 0, %[cl], %[m4]\n\tv_addc_co_u32_e64 %[cl], %[m5], 0, %[cl], %[m5]\n\tv_addc_co_u32_e64 %[cl], %[m6], 0, %[cl], %[m6]\n\tv_addc_co_u32_e64 %[cl], %[m7], 0, %[cl], %[m7]\n\ts_nop 1"
        : [cl] "+v"(cl), [m0] "=&s"(m0), [m1] "=&s"(m1), [m2] "=&s"(m2), [m3] "=&s"(m3), [m4] "=&s"(m4), [m5] "=&s"(m5), [m6] "=&s"(m6), [m7] "=&s"(m7)
        : [c] "s"(cand), [k0] "v"(k0), [k1] "v"(k1), [k2] "v"(k2), [k3] "v"(k3), [k4] "v"(k4), [k5] "v"(k5), [k6] "v"(k6), [k7] "v"(k7));
}
template <int BASE>
DEVI void idx_emit8(unsigned& mlo, unsigned& mhi, unsigned T_, unsigned k0, unsigned k1, unsigned k2, unsigned k3, unsigned k4, unsigned k5, unsigned k6, unsigned k7) {
    u64 m0, m1, m2, m3, m4, m5, m6, m7;
    asm volatile(
        "v_cmp_lt_u32_e64 %[m0], %[c], %[k0]\n\tv_cmp_lt_u32_e64 %[m1], %[c], %[k1]\n\tv_cmp_lt_u32_e64 %[m2], %[c], %[k2]\n\tv_cmp_lt_u32_e64 %[m3], %[c], %[k3]\n\t"
        "v_cmp_lt_u32_e64 %[m4], %[c], %[k4]\n\tv_cmp_lt_u32_e64 %[m5], %[c], %[k5]\n\tv_cmp_lt_u32_e64 %[m6], %[c], %[k6]\n\tv_cmp_lt_u32_e64 %[m7], %[c], %[k7]\n\ts_nop 3"
        : [m0] "=&s"(m0), [m1] "=&s"(m1), [m2] "=&s"(m2), [m3] "=&s"(m3), [m4] "=&s"(m4), [m5] "=&s"(m5), [m6] "=&s"(m6), [m7] "=&s"(m7)
        : [c] "s"(T_), [k0] "v"(k0), [k1] "v"(k1), [k2] "v"(k2), [k3] "v"(k3), [k4] "v"(k4), [k5] "v"(k5), [k6] "v"(k6), [k7] "v"(k7));
    asm volatile(
        "s_nop 3\n\t"
        "v_writelane_b32 %[lo], %[a0], %[i0]\n\tv_writelane_b32 %[hi], %[b0], %[i0]\n\tv_writelane_b32 %[lo], %[a1], %[i1]\n\tv_writelane_b32 %[hi], %[b1], %[i1]\n\t"
        "v_writelane_b32 %[lo], %[a2], %[i2]\n\tv_writelane_b32 %[hi], %[b2], %[i2]\n\tv_writelane_b32 %[lo], %[a3], %[i3]\n\tv_writelane_b32 %[hi], %[b3], %[i3]\n\t"
        "v_writelane_b32 %[lo], %[a4], %[i4]\n\tv_writelane_b32 %[hi], %[b4], %[i4]\n\tv_writelane_b32 %[lo], %[a5], %[i5]\n\tv_writelane_b32 %[hi], %[b5], %[i5]\n\t"
        "v_writelane_b32 %[lo], %[a6], %[i6]\n\tv_writelane_b32 %[hi], %[b6], %[i6]\n\tv_writelane_b32 %[lo], %[a7], %[i7]\n\tv_writelane_b32 %[hi], %[b7], %[i7]\n\ts_nop 1"
        : [lo] "+v"(mlo), [hi] "+v"(mhi)
        : [a0] "s"((unsigned)m0), [b0] "s"((unsigned)(m0 >> 32)), [a1] "s"((unsigned)m1), [b1] "s"((unsigned)(m1 >> 32)), [a2] "s"((unsigned)m2), [b2] "s"((unsigned)(m2 >> 32)),
          [a3] "s"((unsigned)m3), [b3] "s"((unsigned)(m3 >> 32)), [a4] "s"((unsigned)m4), [b4] "s"((unsigned)(m4 >> 32)), [a5] "s"((unsigned)m5), [b5] "s"((unsigned)(m5 >> 32)),
          [a6] "s"((unsigned)m6), [b6] "s"((unsigned)(m6 >> 32)), [a7] "s"((unsigned)m7), [b7] "s"((unsigned)(m7 >> 32)),
          [i0] "n"(BASE), [i1] "n"(BASE + 1), [i2] "n"(BASE + 2), [i3] "n"(BASE + 3), [i4] "n"(BASE + 4), [i5] "n"(BASE + 5), [i6] "n"(BASE + 6), [i7] "n"(BASE + 7));
}
DEVI int idx_count(const unsigned (&kv)[64], int ni, unsigned cand) {
    int cl = 0;
    cand = (unsigned)__builtin_amdgcn_readfirstlane((int)cand);
#pragma unroll
    for (int g8 = 0; g8 < 8; ++g8) {
        if (g8 * 8 < ni) idx_cnt8(cl, cand, kv[g8 * 8], kv[g8 * 8 + 1], kv[g8 * 8 + 2], kv[g8 * 8 + 3], kv[g8 * 8 + 4], kv[g8 * 8 + 5], kv[g8 * 8 + 6], kv[g8 * 8 + 7]);
    }
    return wave_sum_small(cl);
}
struct IdxPre { u32x4 av[2]; unsigned iv[16]; f32x4 w4v[4]; float wv; bf16x8 b0[4], b1[4], b2[4]; };
DEVI void idx_issue(const Params& p, int u, IdxPre& R) {
    const int tid = otid(), wid = __builtin_amdgcn_readfirstlane(tid >> 6), lane = tid & 63, r32 = lane & 31, hi = lane >> 5;
    const int slot = u & 255, ii = u >> 8, b = ii >> 1, g = (ii & 1) ? 511 - slot : slot, t0 = g * 8;
    const size_t tokb = (size_t)b * S;
    if (t0 + 8 > 256) {
        R.wv = 0.5f * p.iw[(tokb + t0) * 16 + (tid & 127)];
        { const int qq = tid >> 6, d = tid & 63;
          const f32x4* wp = (const f32x4*)(p.iw + (tokb + t0 + qq) * 16); const bf16_t* ip = p.iq + (tokb + t0 + qq) * 1024 + d;
#pragma unroll
          for (int h = 0; h < 16; ++h) R.iv[h] = ip[h * 64];
#pragma unroll
          for (int i = 0; i < 4; ++i) R.w4v[i] = wp[i]; }
#pragma unroll
        for (int e = 0; e < 2; ++e) { const int cid = tid + 512 * e, rt = cid >> 8, s4 = (cid >> 6) & 3, ln = cid & 63, rr = ln & 31, hh = ln >> 5;
            const int qs = (rr >> 2) & 1, hd = (rr & 3) | ((rr >> 3) << 2);
            R.av[e] = *(const u32x4*)(p.iq + (tokb + t0 + 2 * rt + qs) * 1024 + hd * 64 + s4 * 16 + hh * 8); }
        const int ntile = ((t0 + 8 + 63) >> 6) * 2;
        const bf16_t* kbase = p.ik + tokb * 64 + (size_t)r32 * 64 + hi * 8;
#pragma unroll
        for (int s = 0; s < 4; ++s) { const int k0 = wid < ntile ? wid : ntile - 1, k1 = wid + 8 < ntile ? wid + 8 : ntile - 1, k2 = wid + 16 < ntile ? wid + 16 : ntile - 1;
            R.b0[s] = *(const bf16x8*)(kbase + (size_t)k0 * 2048 + s * 16); R.b1[s] = *(const bf16x8*)(kbase + (size_t)k1 * 2048 + s * 16); R.b2[s] = *(const bf16x8*)(kbase + (size_t)k2 * 2048 + s * 16); }
    }
}
DEVI void idx_unit(const Params& p, int u, int un, IdxPre& R, unsigned char* smem) {
    const int tid = otid(), wid = __builtin_amdgcn_readfirstlane(tid >> 6), lane = tid & 63;
    const int slot = u & 255, ii = u >> 8, b = ii >> 1, g = (ii & 1) ? 511 - slot : slot, t0 = g * 8;
    unsigned* keys = (unsigned*)smem;
    u64* wl = (u64*)(smem + 131072);
    float* wvl = (float*)(smem + 135168);
    const size_t tokb = (size_t)b * S;
    const int nk64 = (t0 + 8 + 63) >> 6;
    if (t0 + 8 > 256) {
        const int r32 = lane & 31, hi = lane >> 5;
        bf16_t* lin = (bf16_t*)(smem + 135680);
        if (tid < 128) wvl[tid] = R.wv;
        { const int qq = tid >> 6, d = tid & 63;
          float a = 0.f;
#pragma unroll
          for (int i = 0; i < 4; ++i)
#pragma unroll
              for (int jx = 0; jx < 4; ++jx) a = fmaf(0.5f * R.w4v[i][jx], __uint_as_float(R.iv[4 * i + jx] << 16), a);
          const bf16_t hb = f2bf(a); const float rem = a - __uint_as_float((unsigned)hb << 16);
          lin[qq * 64 + d] = hb; lin[512 + qq * 64 + d] = f2bf(rem); if (tid < 64) lin[1024 + tid] = 0; }
        bf16_t* afl = (bf16_t*)(smem + 137984);
#pragma unroll
        for (int e = 0; e < 2; ++e) *(u32x4*)(afl + (tid + 512 * e) * 8) = R.av[e];
        const int ntile = nk64 * 2;
        const bf16_t* kbase = p.ik + tokb * 64 + (size_t)r32 * 64 + hi * 8;
#define IDX_LOADB(dst, kq) do { const int kk_ = (kq) < ntile ? (kq) : ntile - 1; _Pragma("unroll") for (int s = 0; s < 4; ++s) dst[s] = *(const bf16x8*)(kbase + (size_t)kk_ * 2048 + s * 16); } while (0)
        __syncthreads();
        const bf16_t* afp = afl + lane * 8;
        const bf16_t* a5p = lin + ((r32 < 16) ? ((r32 >> 3) * 512 + (2 * (r32 & 3) + ((r32 >> 2) & 1)) * 64 + hi * 8) : 1024);
#define IDX_AF(rt, s) (*(const bf16x8*)(afp + ((rt) * 4 + (s)) * 512))
#define IDX_M1(bc) do { acc0 = f32x16{}; acc1 = f32x16{}; acc5 = f32x16{};                                                    \
            _Pragma("unroll") for (int s = 0; s < 4; ++s) {                                                                    \
                acc0 = __builtin_amdgcn_mfma_f32_32x32x16_bf16(IDX_AF(0, s), bc[s], acc0, 0, 0, 0);                           \
                acc1 = __builtin_amdgcn_mfma_f32_32x32x16_bf16(IDX_AF(1, s), bc[s], acc1, 0, 0, 0);                           \
                acc5 = __builtin_amdgcn_mfma_f32_32x32x16_bf16(*(const bf16x8*)(a5p + s * 16), bc[s], acc5, 0, 0, 0); }      \
            __builtin_amdgcn_sched_barrier(0); } while (0)
#define IDX_M2(bc) do { acc2 = f32x16{}; acc3 = f32x16{};                                                                     \
            _Pragma("unroll") for (int s = 0; s < 4; ++s) {                                                                    \
                acc2 = __builtin_amdgcn_mfma_f32_32x32x16_bf16(IDX_AF(2, s), bc[s], acc2, 0, 0, 0);                           \
                acc3 = __builtin_amdgcn_mfma_f32_32x32x16_bf16(IDX_AF(3, s), bc[s], acc3, 0, 0, 0); }                         \
            __builtin_amdgcn_sched_barrier(0); } while (0)
#define IDX_EPI(ACC, LIN, rt, kt_) do {                                                                                     \
                const int myq = 2 * (rt) + hi, key = (kt_) * 32 + r32;                                                        \
                const f32x4* wp = (const f32x4*)(wvl + myq * 16);                                                             \
                float sc = (LIN);                                                                                             \
                _Pragma("unroll") for (int i = 0; i < 4; ++i) { const f32x4 w4 = wp[i];                                       \
                    _Pragma("unroll") for (int jx = 0; jx < 4; ++jx) sc = fmaf(w4[jx], fabsf(ACC[4 * i + jx]), sc); }         \
                const unsigned bits = __float_as_uint(sc);                                                                    \
                unsigned kk = bits ^ ((unsigned)((int)bits >> 31) | 0x80000000u);                                             \
                if (key > t0 + myq) kk = 0u;                                                                                  \
                keys[myq * 4096 + key] = kk; } while (0)
#define IDX_E1(kt_) do { lin2 = acc5[2] + acc5[6]; lin3 = acc5[3] + acc5[7];                                                  \
            IDX_EPI(acc0, acc5[0] + acc5[4], 0, kt_); IDX_EPI(acc1, acc5[1] + acc5[5], 1, kt_); __builtin_amdgcn_sched_barrier(0); } while (0)
#define IDX_E2(kt_) do { IDX_EPI(acc2, lin2, 2, kt_); IDX_EPI(acc3, lin3, 3, kt_); __builtin_amdgcn_sched_barrier(0); } while (0)
#define IDX_STEP(bx, by) { IDX_M2(bx); IDX_LOADB(bx, kt + 24); __builtin_amdgcn_sched_barrier(0); IDX_E1(kt);                  \
            const bool more_ = kt + 8 < ntile; if (more_) IDX_M1(by); IDX_E2(kt); kt += 8; if (!more_) break; }
        {
            f32x16 acc0, acc1, acc2, acc3, acc5; float lin2, lin3;
            int kt = wid;
            if (kt < ntile) {
                IDX_M1(R.b0);
                for (;;) { IDX_STEP(R.b0, R.b1) IDX_STEP(R.b1, R.b2) IDX_STEP(R.b2, R.b0) }
            }
        }
#undef IDX_STEP
#undef IDX_E2
#undef IDX_E1
#undef IDX_EPI
#undef IDX_M2
#undef IDX_M1
#undef IDX_AF
#undef IDX_LOADB
    }
    __syncthreads();
    if (un >= 0) idx_issue(p, un, R);
#pragma unroll 1
    for (int rep = 0; rep < 1 + (PROBE_REP == 9); ++rep)
    {
        const int tq = t0 + wid, n = tq + 1;
        u64 myword = 0;
        if (n <= 256) {
            const int lo = lane * 64;
            myword = (tq >= lo + 63) ? ~0ull : (tq < lo ? 0ull : ((1ull << (tq - lo + 1)) - 1ull));
        } else {
            const int ni = (n + 63) >> 6;
            unsigned kv[64];
#pragma unroll
            for (int i = 0; i < 64; ++i) { const unsigned vv = keys[wid * 4096 + i * 64 + lane]; kv[i] = (i < ni) ? vv : 0u; }
            unsigned kmax = 0;
#pragma unroll
            for (int i = 0; i < 64; ++i) kmax = kv[i] > kmax ? kv[i] : kmax;
#pragma unroll
            for (int o = 32; o > 0; o >>= 1) { const unsigned ot = (unsigned)__shfl_xor((int)kmax, o); kmax = ot > kmax ? ot : kmax; }
            kmax = (unsigned)__builtin_amdgcn_readfirstlane((int)kmax);
            unsigned lo = 1u, hi = kmax + 1u; int c_lo = n, c_hi = 0; bool exact = false;
            { unsigned cand = kmax & 0xFF800000u;
#pragma unroll 1
              for (int st = 0; st < 4 && cand >= 0x00800000u; ++st) {
                  const int c = idx_count(kv, ni, cand);
                  if (c >= 256) { lo = cand; c_lo = c; exact = (c == 256); break; }
                  hi = cand; c_hi = c; cand -= 0x00800000u;
              } }
            if (!exact) {
#pragma unroll 1
                while (hi - lo > 1u && c_lo - c_hi > 64) {
                    const unsigned mid = lo + ((hi - lo) >> 1);
                    const int c = idx_count(kv, ni, mid);
                    if (c == 256) { lo = mid; exact = true; break; }
                    if (c > 256) { lo = mid; c_lo = c; } else { hi = mid; c_hi = c; }
                }
            }
            if (!exact && hi - lo > 1u) {
                unsigned* slot = (unsigned*)(wl + wid * 64);
                int base = 0; const unsigned span = hi - lo;
#pragma unroll
                for (int i = 0; i < 64; ++i) {
                    const bool inb = (kv[i] - lo) < span;
                    const u64 bb = __ballot(inb);
                    if (bb != 0ull) {
                        const int off = base + (int)__builtin_amdgcn_mbcnt_hi((unsigned)(bb >> 32), __builtin_amdgcn_mbcnt_lo((unsigned)bb, 0u));
                        if (inb) slot[off] = kv[i];
                        base += __popcll(bb);
                    }
                }
                const unsigned mine = (lane < base) ? slot[lane] : 0u;
                const int c_above = c_hi;
#pragma unroll 1
                while (hi - lo > 1u) {
                    const unsigned mid = lo + ((hi - lo) >> 1);
                    const int c = c_above + __popcll(__ballot(mine >= mid));
                    if (c == 256) { lo = mid; exact = true; break; }
                    if (c > 256) { lo = mid; c_lo = c; } else { hi = mid; c_hi = c; }
                }
            }
            const unsigned prefix = lo;
            unsigned Tt; int need;
            if (exact) { Tt = prefix - 1u; need = 0; }
            else { Tt = prefix; need = 256 - c_hi; }
            if (need == 0) {
                unsigned mlo = 0u, mhi = 0u; const unsigned Ts = (unsigned)__builtin_amdgcn_readfirstlane((int)Tt);
#define EMIT8(G) idx_emit8<G * 8>(mlo, mhi, Ts, kv[G * 8], kv[G * 8 + 1], kv[G * 8 + 2], kv[G * 8 + 3], kv[G * 8 + 4], kv[G * 8 + 5], kv[G * 8 + 6], kv[G * 8 + 7])
                EMIT8(0); EMIT8(1); EMIT8(2); EMIT8(3); EMIT8(4); EMIT8(5); EMIT8(6); EMIT8(7);
#undef EMIT8
                myword = ((u64)mhi << 32) | mlo;
            } else {
#pragma unroll
                for (int i = 0; i < 64; ++i) {
                    u64 m = __ballot(kv[i] > Tt);
                    if (need > 0) {
                        u64 me = __ballot(kv[i] == Tt);
                        const int pc = __popcll(me), take = pc < need ? pc : need;
                        while (__popcll(me) > take) me &= ~(1ull << (63 - __clzll(me)));
                        need -= take; m |= me;
                    }
                    if (lane == i) myword = m;
                }
            }
        }
        wl[wid * 64 + lane] = myword;
    }
    __syncthreads();
    { const int jj = tid >> 3, qq = tid & 7; p.bm[((size_t)b * 64 + jj) * S + t0 + qq] = wl[qq * 64 + jj]; }
    __syncthreads();
}

constexpr int RL_XIN = 0, RL_XCU = 46592, RL_XA = 91648, RL_SAGG = 116224, RL_CAR = 119040, RL_HALO = 120448, RL_CONST = 121600, RL_WG = 124544, RL_WSTR = 104;
DEVI void rnn_quarter(const Params& p, int l, int sq, unsigned char* smem, bool dry) {
    const int tid = otid(), wid = __builtin_amdgcn_readfirstlane(tid >> 6), lane = tid & 63;
    const int n = sq & 15, q = (sq >> 4) & 3, b = sq >> 6;
    float* xin = (float*)(smem + RL_XIN);
    float* xcu = (float*)(smem + RL_XCU);
    bf16_t* xa = (bf16_t*)(smem + RL_XA);
    f32x2* sagg = (f32x2*)(smem + RL_SAGG);
    f32x2* car = (f32x2*)(smem + RL_CAR);
    float* halo = (float*)(smem + RL_HALO);
    float* cst = (float*)(smem + RL_CONST);
    bf16_t* wg = (bf16_t*)(smem + RL_WG);
    const int fr = lane & 15, fq = lane >> 4;
    const int sc_ = tid % 88, sg = tid / 88;
    {
        const bf16_t* Wg = (l ? p.Wsm1 : p.Wsm0) + OFF_WG;
        for (int c = tid; c < 2 * 88 * 12; c += 512) { const int gsel = c / (88 * 12), r = (c / 12) % 88, k8 = c % 12;
            *(u32x4*)(wg + (gsel * 88 + r) * RL_WSTR + k8 * 8) = *(const u32x4*)(Wg + (((size_t)gsel * 16 + n) * 96 + r) * 96 + k8 * 8); }
        if (tid < 96) { const int gc = l * DR + n * 88 + tid; const bool ok = tid < 88;
            cst[tid] = ok ? p.b_rg[gc] : 0.f; cst[96 + tid] = ok ? p.b_ig[gc] : 0.f; cst[192 + tid] = ok ? log1pf(__expf(-p.lam[gc])) : 0.f; }
        if (tid >= 128 && tid < 128 + 88) { const int c = tid - 128; const float* cw = p.conv_w + (size_t)l * 4 * DR + n * 88 + c;
            cst[288 + c] = cw[0]; cst[288 + 88 + c] = cw[DR]; cst[288 + 176 + c] = cw[2 * DR]; cst[288 + 264 + c] = cw[3 * DR]; cst[288 + 352 + c] = p.conv_b[(size_t)l * DR + n * 88 + c]; }
        if (tid >= 256 && tid < 256 + 88) car[tid - 256] = (f32x2){1.f, 0.f};
        if (tid >= 384 && tid < 384 + 33) { const int c = tid - 384, r = c / 11, cc = c - r * 11;
            f32x4 a0 = {0.f, 0.f, 0.f, 0.f}, a1 = a0;
            if (q > 0) load8f(p.halo + ((size_t)(b * 4 + q - 1) * 3 + r) * DR + n * 88 + cc * 8, a0, a1);
            *(f32x4*)(halo + r * 88 + cc * 8) = a0; *(f32x4*)(halo + r * 88 + cc * 8 + 4) = a1; }
    }
    __syncthreads();
    const float cw0 = cst[288 + sc_], cw1 = cst[288 + 88 + sc_], cw2 = cst[288 + 176 + sc_], cw3 = cst[288 + 264 + sc_], cbv = cst[288 + 352 + sc_];
    u32x4 xw[3], gw[3], xwn[3];
#define RNN_LOADX(dst, tk) do { _Pragma("unroll") for (int i = 0; i < 3; ++i) { const int c = tid + 512 * i, r = c / 11, cc = c - r * 11; \
            dst[i] = (u32x4){0u, 0u, 0u, 0u}; if (c < 128 * 11) dst[i] = *(const u32x4*)(p.xr + ((tk) + r) * DR + n * 88 + cc * 8); } } while (0)
    RNN_LOADX(xw, (size_t)b * S + q * 1024);
#pragma unroll 1
    for (int jc = 0; jc < 8; ++jc) {
        const int t0 = q * 1024 + jc * 128; const size_t tok0 = (size_t)b * S + t0;
#pragma unroll
        for (int i = 0; i < 3; ++i) { const int c = tid + 512 * i, r = c / 11, cc = c - r * 11;
            gw[i] = (u32x4){0u, 0u, 0u, 0u};
            if (c < 128 * 11) gw[i] = *(const u32x4*)(p.sgr + (tok0 + r) * DR + n * 88 + cc * 8); }
        if (tid < 264) xin[tid] = halo[tid];
#pragma unroll
        for (int i = 0; i < 3; ++i) { const int c = tid + 512 * i;
            if (c < 128 * 11) { const u32x4 w = xw[i]; float* d = xin + 264 + c * 8;
                *(f32x4*)d = (f32x4){bf_lo(w.x), bf_hi(w.x), bf_lo(w.y), bf_hi(w.y)}; *(f32x4*)(d + 4) = (f32x4){bf_lo(w.z), bf_hi(w.z), bf_lo(w.w), bf_hi(w.w)}; } }
        __syncthreads();
        if (jc < 7) RNN_LOADX(xwn, tok0 + 128);
        if (tid < 264) halo[tid] = xin[128 * 88 + tid];
        if (tid < 440) {
            const int tb0 = sg * 26;
            float x0 = xin[tb0 * 88 + sc_], x1 = xin[(tb0 + 1) * 88 + sc_], x2 = xin[(tb0 + 2) * 88 + sc_];
#pragma unroll
            for (int tt = 0; tt < 26; tt += 13) {
                float xn[13];
#pragma unroll
                for (int e = 0; e < 13; ++e) { const int t = tb0 + tt + e; xn[e] = (t < 128) ? xin[(t + 3) * 88 + sc_] : 0.f; }
#pragma unroll
                for (int e = 0; e < 13; ++e) { const int t = tb0 + tt + e;
                    const float vv = cbv + cw0 * x0 + cw1 * x1 + cw2 * x2 + cw3 * xn[e];
                    if (t < 128) { xcu[t * 88 + sc_] = vv; xa[t * 96 + sc_] = f2bf(vv); }
                    x0 = x1; x1 = x2; x2 = xn[e]; }
            }
        } else { for (int e = tid - 440; e < 128 * 8; e += 72) xa[(e >> 3) * 96 + 88 + (e & 7)] = 0; }
        __syncthreads();
        f32x2* wagg = (f32x2*)(smem + RL_XA);
        f32x2* wcar = wagg + 8 * 88;
        float* aout = xin;
        {
            bf16x8 a[3];
#pragma unroll
            for (int s3 = 0; s3 < 3; ++s3) a[s3] = *(const bf16x8*)(xa + (wid * 16 + fr) * 96 + s3 * 32 + fq * 8);
            __syncthreads();
#pragma unroll
            for (int nt = 0; nt < 6; ++nt) {
                f32x4 accr = {0.f, 0.f, 0.f, 0.f}, acci = accr;
                const bf16_t* wr_ = wg + (nt * 16 + fr) * RL_WSTR + fq * 8; const bf16_t* wi_ = wr_ + 88 * RL_WSTR;
#pragma unroll
                for (int s3 = 0; s3 < 3; ++s3) {
                    accr = __builtin_amdgcn_mfma_f32_16x16x32_bf16(a[s3], *(const bf16x8*)(wr_ + s3 * 32), accr, 0, 0, 0);
                    acci = __builtin_amdgcn_mfma_f32_16x16x32_bf16(a[s3], *(const bf16x8*)(wi_ + s3 * 32), acci, 0, 0, 0);
                }
                const int c = nt * 16 + fr; const bool okc = c < 88; const int cs = okc ? c : 87;
                const float brg = cst[cs], big = cst[96 + cs], sp = cst[192 + cs];
                float Pl[4], hl[4];
                { float P = 1.f, h = 0.f;
#pragma unroll
                  for (int r = 0; r < 4; ++r) {
                      const int t = wid * 16 + fq * 4 + r;
                      const float rg = sigmoidf_(accr[r] + brg), ig = sigmoidf_(acci[r] + big);
                      const float la = -8.0f * rg * sp, av = __expf(la), mult = __builtin_amdgcn_sqrtf(-expm1_small(2.0f * la));
                      const float uv = mult * ig * xcu[t * 88 + cs];
                      h = av * h + uv; P *= av; Pl[r] = P; hl[r] = h; } }
                float Pg = Pl[3], hg = hl[3];
                { const float Pp = __shfl_up(Pg, 16), hp = __shfl_up(hg, 16); if (fq >= 1) { hg = Pg * hp + hg; Pg = Pp * Pg; } }
                { const float Pp = __shfl_up(Pg, 32), hp = __shfl_up(hg, 32); if (fq >= 2) { hg = Pg * hp + hg; Pg = Pp * Pg; } }
                float Pe = __shfl_up(Pg, 16), he = __shfl_up(hg, 16); if (fq == 0) { Pe = 1.f; he = 0.f; }
                if (okc) {
#pragma unroll
                    for (int r = 0; r < 4; ++r) { const int t = wid * 16 + fq * 4 + r; aout[t * 88 + c] = Pe * Pl[r]; xcu[t * 88 + c] = Pl[r] * he + hl[r]; }
                    if (fq == 3) wagg[wid * 88 + c] = (f32x2){Pg, hg};
                }
            }
        }
        __syncthreads();
        if (tid < 88) {
            f32x2 cr = car[(jc & 1) * 88 + tid]; float P = cr[0], h = cr[1];
#pragma unroll
            for (int w8 = 0; w8 < 8; ++w8) { wcar[w8 * 88 + tid] = (f32x2){P, h}; const f32x2 gq = wagg[w8 * 88 + tid]; h = gq[0] * h + gq[1]; P *= gq[0]; }
            car[((jc + 1) & 1) * 88 + tid] = (f32x2){P, h};
        }
        __syncthreads();
#pragma unroll
        for (int i = 0; i < 3; ++i) { const int c = tid + 512 * i, r = c / 11, cc = c - r * 11;
            if (c < 128 * 11) {
                const u32x4 w = gw[i];
                const f32x4 g0 = {bf_lo(w.x), bf_hi(w.x), bf_lo(w.y), bf_hi(w.y)}, g1 = {bf_lo(w.z), bf_hi(w.z), bf_lo(w.w), bf_hi(w.w)};
                const float* hp = xcu + c * 8; const float* pp = aout + c * 8;
                const f32x2* wcp = wcar + (r >> 4) * 88 + cc * 8;
                f32x4 cP0, cP1, cH0, cH1;
#pragma unroll
                for (int e = 0; e < 4; ++e) { const f32x2 w0 = wcp[e], w1 = wcp[4 + e]; cP0[e] = w0[0]; cH0[e] = w0[1]; cP1[e] = w1[0]; cH1[e] = w1[1]; }
                const f32x4 pl0 = *(const f32x4*)pp, pl1 = *(const f32x4*)(pp + 4);
                const f32x4 hh0 = *(const f32x4*)hp + pl0 * cH0, hh1 = *(const f32x4*)(hp + 4) + pl1 * cH1;
                if (!dry) store8(p.sgr + (tok0 + r) * DR + n * 88 + cc * 8, g0 * hh0, g1 * hh1);
                if (q > 0 && !dry) store8(p.xr + (tok0 + r) * DR + n * 88 + cc * 8, g0 * (pl0 * cP0), g1 * (pl1 * cP1));
            } }
#pragma unroll
        for (int i = 0; i < 3; ++i) xw[i] = xwn[i];
        __syncthreads();
    }
#undef RNN_LOADX
    if (tid < 88) *(f32x2*)(p.agg + (((size_t)b * 4 + q) * DR + n * 88 + tid) * 2) = car[tid];
    __syncthreads();
}
DEVI void rnn_fix(const Params& p, int task, unsigned char* smem) {
    const int tid = otid();
    const int sidx = task >> 2, sub = task & 3;
    const int b = sidx / 48, rem = sidx - b * 48, q = 1 + rem / 16, n = rem & 15;
    float* Cq = (float*)smem;
    if (tid < 88) { float h = 0.f;
        for (int qq = 0; qq < q; ++qq) { const f32x2 gq = *(const f32x2*)(p.agg + (((size_t)b * 4 + qq) * DR + n * 88 + tid) * 2); h = gq[0] * h + gq[1]; }
        Cq[tid] = h; }
    __syncthreads();
    const size_t tok0 = (size_t)b * S + q * 1024 + sub * 256;
    u32x4 hv[6], sv[6];
#pragma unroll
    for (int i = 0; i < 6; ++i) { const int c = tid + 512 * i, r = c / 11, cc = c - r * 11;
        if (c < 256 * 11) { hv[i] = *(const u32x4*)(p.sgr + (tok0 + r) * DR + n * 88 + cc * 8); sv[i] = *(const u32x4*)(p.xr + (tok0 + r) * DR + n * 88 + cc * 8); } }
#pragma unroll
    for (int i = 0; i < 6; ++i) { const int c = tid + 512 * i, r = c / 11, cc = c - r * 11;
        if (c < 256 * 11) {
            const u32x4 hw = hv[i], sw = sv[i];
            const f32x4 h0 = {bf_lo(hw.x), bf_hi(hw.x), bf_lo(hw.y), bf_hi(hw.y)}, h1 = {bf_lo(hw.z), bf_hi(hw.z), bf_lo(hw.w), bf_hi(hw.w)};
            const f32x4 s0 = {bf_lo(sw.x), bf_hi(sw.x), bf_lo(sw.y), bf_hi(sw.y)}, s1 = {bf_lo(sw.z), bf_hi(sw.z), bf_lo(sw.w), bf_hi(sw.w)};
            const f32x4 c0 = *(const f32x4*)(Cq + cc * 8), c1 = *(const f32x4*)(Cq + cc * 8 + 4);
            store8(p.sgr + (tok0 + r) * DR + n * 88 + cc * 8, h0 + s0 * c0, h1 + s1 * c1); } }
    __syncthreads();
}

DEVI void phase_prep_rows(const Params& p) {
    const int tid_ = otid(), wid = tid_ >> 6, lane = tid_ & 63;
    for (int row = blockIdx.x * 8 + wid; row < T; row += gridDim.x * 8) {
        const f32x4* xp = (const f32x4*)(p.x + (size_t)row * 1024);
        float s = 0.f;
#pragma unroll
        for (int i = 0; i < 4; ++i) { const f32x4 vv = __builtin_nontemporal_load(xp + i * 64 + lane); s += (vv[0] * vv[0] + vv[1] * vv[1]) + (vv[2] * vv[2] + vv[3] * vv[3]);
            u32x2 w; w.x = cvtpk(vv[0], vv[1]); w.y = cvtpk(vv[2], vv[3]); *(u32x2*)(p.xb + (size_t)row * 1024 + (i * 64 + lane) * 4) = w; }
        s = wave_sum(s);
        if (lane < 16) p.ssq[(size_t)row * 16 + lane] = (lane == 0) ? s : 0.f;
    }
}
DEVI int win_src_col(int np) {
    const int pn = np >> 8, pp = np & 255, bj = pp >> 7, o = pp & 127;
    if (pn < 8) { const int hsel = o >> 6, i = o & 63; return (pn >= 4 ? 1024 : 0) + (2 * (pn & 3) + hsel) * 128 + bj * 64 + i; }
    if (pn < 12) return 2048 + (pn - 8) * 256 + pp;
    if (pn < 16) { const int hsel = o >> 5, i = o & 31; return 4096 + (4 * (pn - 12) + hsel) * 64 + bj * 32 + i; }
    if (pn < 27) return 5200 + (pn - 16) * 256 + pp;
    if (pn == 27) { if (bj == 0) { if (o < 32) return 5120 + o; if (o < 48) return 5184 + (o - 32); return -1; } else { if (o < 32) return 5152 + o; return -1; } }
    if (pn < 32) return 3072 + (pn - 28) * 256 + pp;
    if (pn < 36) return 8016 + (pn - 32) * 256 + pp;
    return 9040 + (pn - 36) * 256 + pp;
}
template <bool SCALE, bool WINMAP>
DEVI void conv_tile(const float* src, int ldsrc, int K, const float* scale, bf16_t* dst, int n0, int k0, unsigned char* smem) {
    float* tile = (float*)smem;
    const int tid = otid(), w = tid >> 6, lane = tid & 63;
    const int sc = WINMAP ? win_src_col(n0 + lane) : (n0 + lane);
    const int scs = sc < 0 ? 0 : sc; const float msk = sc < 0 ? 0.f : 1.f;
    float vv[8], gg[8];
#pragma unroll
    for (int r = 0; r < 8; ++r) { vv[r] = __builtin_nontemporal_load(src + (size_t)(k0 + w * 8 + r) * ldsrc + scs); gg[r] = SCALE ? scale[k0 + w * 8 + r] : 1.f; }
#pragma unroll
    for (int r = 0; r < 8; ++r) tile[(w * 8 + r) * 65 + lane] = vv[r] * gg[r] * msk;
    __syncthreads();
    { const int nn = tid >> 3, k8 = (tid & 7) * 8; f32x4 a0, a1;
#pragma unroll
      for (int e = 0; e < 4; ++e) { a0[e] = tile[(k8 + e) * 65 + nn]; a1[e] = tile[(k8 + 4 + e) * 65 + nn]; }
      store8(dst + (size_t)(n0 + nn) * K + k0 + k8, a0, a1); }
    __syncthreads();
}
DEVI void convert_big(const Params& p, int l, unsigned char* smem, int first, int stride) {
    const float* src = p.w_in + (size_t)l * 1024 * NIN; const float* g = p.norm_g + (size_t)l * 1024;
    for (int i = first; i < 160 * 16; i += stride) conv_tile<true, true>(src, NIN, 1024, g, p.WinT, (i >> 4) * 64, (i & 15) * 64, smem);
}
DEVI void convert_small(const Params& p, int l, unsigned char* smem, int first, int stride) {
    bf16_t* W = l ? p.Wsm1 : p.Wsm0;
    for (int i = first; i < 256 + 352 + 256; i += stride) {
        if (i < 256) conv_tile<false, false>(p.w_oa + (size_t)l * 1024 * 1024, 1024, 1024, nullptr, W + OFF_WA, (i >> 4) * 64, (i & 15) * 64, smem);
        else if (i < 608) { const int ii = i - 256; conv_tile<false, false>(p.w_or + (size_t)l * DR * 1024, 1024, DR, nullptr, W + OFF_WB, (ii / 22) * 64, (ii % 22) * 64, smem); }
        else { const int ii = i - 608; conv_tile<false, false>(p.w_o + (size_t)l * 1024 * 1024, 1024, 1024, nullptr, W + OFF_WO, (ii >> 4) * 64, (ii & 15) * 64, smem); }
    }
    for (int e = first * 512 + otid(); e < 2 * 16 * 96 * 96; e += stride * 512) {
        const int k = e % 96, nn = (e / 96) % 96, blk = (e / 9216) % 16, gsel = e / (9216 * 16);
        float vv = 0.f;
        if (k < 88 && nn < 88) vv = (gsel ? p.w_ig : p.w_rg)[(((size_t)l * 16 + blk) * 88 + k) * 88 + nn];
        W[OFF_WG + e] = f2bf(vv);
    }
}
DEVI void phase_final(const Params& p) {
    const int tid_ = otid(), wid = tid_ >> 6, lane = tid_ & 63;
    for (int row = blockIdx.x * 8 + wid; row < T; row += gridDim.x * 8) {
        const float rs = row_rstd(p.ssq, row);
        f32x4* xp = (f32x4*)(p.out + (size_t)row * 1024); const f32x4* gp = (const f32x4*)p.fin_g;
#pragma unroll
        for (int i = 0; i < 4; ++i) { const f32x4 vv = xp[i * 64 + lane], gg = gp[i * 64 + lane]; __builtin_nontemporal_store(vv * rs * gg, xp + i * 64 + lane); }
    }
}


#define XB_TMO      128
#define XB_XCNT(j)  (256  + 64 * (j))
#define XB_XSUB(j)  (1280 + 64 * (j))
#define XB_XGEN(j)  (2304 + 64 * (j))
#define XB_TOP      3328
#define XB_TOPGEN   3392
#define XCD_BAR_WORDS 3456
#define XB_SPIN_CAP (1u << 18)
DEVI unsigned xb_ld(unsigned* p)              { return __hip_atomic_load(p, __ATOMIC_RELAXED, __HIP_MEMORY_SCOPE_AGENT); }
DEVI unsigned xb_add(unsigned* p, unsigned v) { return __hip_atomic_fetch_add(p, v, __ATOMIC_RELAXED, __HIP_MEMORY_SCOPE_AGENT); }
DEVI unsigned xb_xcc_id() { return (unsigned)__builtin_amdgcn_s_getreg((3 << 11) | 20) & 0xFu; }
#define XB_SPIN(cond, bar) do { unsigned _sp = 0; while (cond) { __builtin_amdgcn_s_sleep(1); \
    if ((++_sp & 255u) == 0u) { if (xb_ld(&(bar)[XB_TMO])) break; if (_sp > XB_SPIN_CAP) { atomicAdd(&(bar)[XB_TMO], 1u); break; } } } } while (0)
struct XcdBarrier { unsigned* bar; unsigned x; volatile LAS unsigned* st; };
DEVI XcdBarrier xcd_barrier_post(unsigned* bar, volatile LAS unsigned* st) {
    XcdBarrier b; b.bar = bar; b.x = xb_xcc_id(); b.st = st;
    if (threadIdx.x == 0) (void)xb_add(&bar[XB_XCNT(b.x)], 1u);
    return b;
}
DEVI void xcd_barrier_complete(unsigned* bar, unsigned x, unsigned& nloc, unsigned& nx) {
    const unsigned G = gridDim.x * gridDim.y * gridDim.z;
    unsigned sum, cnt, mine, sp = 0u;
    for (;;) {
        sum = 0u; cnt = 0u; mine = 0u;
#pragma unroll
        for (unsigned j = 0; j < 16; ++j) { const unsigned c = xb_ld(&bar[XB_XCNT(j)]); sum += c; cnt += (c > 0u) ? 1u : 0u; mine = (j == x) ? c : mine; }
        if (sum == G) break;
        __builtin_amdgcn_s_sleep(1);
        if ((++sp & 255u) == 0u) { if (xb_ld(&bar[XB_TMO])) break; if (sp > XB_SPIN_CAP) { atomicAdd(&bar[XB_TMO], 1u); break; } }
    }
    nloc = mine > 0u ? mine : 1u; nx = cnt > 0u ? cnt : 1u;
}
DEVI void xcd_barrier(const XcdBarrier& b) {
    asm volatile("s_waitcnt vmcnt(0)" ::: "memory");
    __syncthreads();
    if (threadIdx.x == 0) {
        unsigned* bar = b.bar;
        __builtin_amdgcn_s_waitcnt(0);
        unsigned nloc = b.st[0], nx = b.st[1];
        if (nloc == 0u) { xcd_barrier_complete(bar, b.x, nloc, nx); b.st[0] = nloc; b.st[1] = nx; }
        const unsigned old = xb_add(&bar[XB_XSUB(b.x)], 1u);
        const unsigned gen = old / nloc;
        if (old + 1u == (gen + 1u) * nloc) {
            __builtin_amdgcn_fence(__ATOMIC_RELEASE, "agent");
            asm volatile("s_waitcnt vmcnt(0)" ::: "memory");
            const unsigned og = xb_add(&bar[XB_TOP], 1u);
            const unsigned tg = og / nx;
            if (og + 1u == (tg + 1u) * nx) xb_add(&bar[XB_TOPGEN], 1u);
            else XB_SPIN(xb_ld(&bar[XB_TOPGEN]) == tg, bar);
            __builtin_amdgcn_fence(__ATOMIC_ACQUIRE, "agent");
            xb_add(&bar[XB_XGEN(b.x)], 1u);
            asm volatile("s_waitcnt vmcnt(0)" ::: "memory");
        } else {
            XB_SPIN(xb_ld(&bar[XB_XGEN(b.x)]) == gen, bar);
            __builtin_amdgcn_fence(__ATOMIC_ACQUIRE, "agent");
            asm volatile("s_waitcnt vmcnt(0)" ::: "memory");
        }
    }
    __syncthreads();
}

DEVI void run_phase(const Params& p, int ph, unsigned char* smem) {
    LAS unsigned char* lds = (LAS unsigned char*)smem;
    const int G = gridDim.x, c = blockIdx.x;
    if (ph == 0) {
        phase_prep_rows(p);
        for (int rep = 0; rep < 1 + (PROBE_REP == 5); ++rep)
        convert_big(p, 0, smem, c, G);
        convert_small(p, 0, smem, c, G);
        return;
    }
    if (ph == NPH - 1) { phase_final(p); return; }
    const int l = (ph - 1) / 6, kind = (ph - 1) % 6;
    const bf16_t* Wsm = l ? p.Wsm1 : p.Wsm0;
    bf16_t* sma = p.iq; bf16_t* smb = p.xr; bf16_t* yag = p.k; bf16_t* merged = p.v; bf16_t* ag = p.q; bf16_t* hg = p.sgr;
    pg8::StaticOrder so;
    if (kind == 0) {
        pg8::Gemm g{p.xb, p.WinT, T, 28 * 256, 1024}; so.init(g.M, g.N, G, c);
        fill_rstd(p.ssq, p.pos, so, smem);
        EpiPA1 e{(const float*)(smem + RS_OFF), p.pos, p.q, p.k, p.v, p.iq, p.ik, p.xr, p.sgr, p.iw, p.halo};
        if (PROBE_REP == 11) { EpiTriv et{p.v}; pg8::gemm_phase(lds, g, so, et); }
        for (int rep = 0; rep < 1 + (PROBE_REP == 3); ++rep)
        pg8::gemm_phase(lds, g, so, e);
    } else if (kind == 1) {
#ifndef SKIP_IDX
        { IdxPre R; idx_issue(p, c, R);
          for (int u = c; u < 2048; u += G) idx_unit(p, u, (u + G < 2048) ? u + G : -1, R, smem); }
#endif
        if (PROBE_REP == 2) { for (int sq = c; sq < 256; sq += G) rnn_quarter(p, l, sq, smem, true); }
        for (int sq = c; sq < 256; sq += G) rnn_quarter(p, l, sq, smem, false);
    } else if (kind == 2) {
#ifndef SKIP_ATT
        if (PROBE_REP == 4) phase_attention(p, smem, p.iq);
        phase_attention(p, smem, p.q);
#endif
        for (int tk = c; tk < 768; tk += G) rnn_fix(p, tk, smem);
        if (l == 0) convert_small(p, 1, smem, c, G);
    } else if (kind == 3) {
        pg8::Gemm g{p.xb, p.WinT + (size_t)28 * 256 * 1024, T, 12 * 256, 1024}; so.init(g.M, g.N, G, c);
        fill_rstd(p.ssq, p.pos, so, smem);
        EpiPA2 e{(const float*)(smem + RS_OFF), ag, sma, smb};
        pg8::gemm_phase(lds, g, so, e);
    } else if (kind == 4) {
        for (int rep = 0; rep < 1 + (PROBE_REP == 6); ++rep) {
        { pg8::Gemm g{ag, Wsm + OFF_WA, T, 1024, 1024}; so.init(g.M, g.N, G, c);
          EpiPD<0> e{sma, nullptr, yag}; pg8::gemm_phase(lds, g, so, e); }
        { pg8::Gemm g{hg, Wsm + OFF_WB, T, 1024, DR}; so.init(g.M, g.N, G, c);
          EpiPD<1> e{smb, yag, merged}; pg8::gemm_phase(lds, g, so, e); }
        }
        if (l == 0) convert_big(p, 1, smem, c, G);
    } else {
        pg8::Gemm g{merged, Wsm + OFF_WO, T, 1024, 1024}; so.init(g.M, g.N, G, c);
        EpiPE e{l == 0 ? p.x : p.out, p.out, p.xb, p.ssq};
        pg8::gemm_phase(lds, g, so, e);
    }
}

__global__ void __launch_bounds__(512, 2) hybrid_fwd(Params p, int ph_lo, int ph_hi) {
    extern __shared__ __attribute__((aligned(16))) unsigned char smem[];
    volatile LAS unsigned* st = (volatile LAS unsigned*)((LAS unsigned char*)smem + (LDS_BYTES - 16));
    if (threadIdx.x == 0) { st[0] = 0u; st[1] = 0u; }
    __syncthreads();
    const XcdBarrier bar = xcd_barrier_post(p.bar, st);
    if (ph_hi < 0) cg::this_grid().sync();
    if (PROBE_REP == 10) { for (int i = 0; i < 20; ++i) xcd_barrier(bar); }
    for (int ph = ph_lo; ph < ph_hi; ++ph) {
        if (ph > ph_lo) xcd_barrier(bar);
        run_phase(p, ph, smem);
    }
}

extern "C" void kernel_launch(void* const* d_in, const int* in_sizes, int n_in, void* d_out, int out_size, void* d_ws, size_t ws_size, hipStream_t stream) {
    static int grid = 0;
    size_t off = 0; auto take = [&](size_t bytes) { size_t o = off; off += (bytes + 255) & ~(size_t)255; return o; };
    const size_t o_WinT = take((size_t)10240 * 1024 * 2), o_W0 = take(WSM_ELEMS * 2), o_W1 = take(WSM_ELEMS * 2);
    const size_t o_xb = take((size_t)T * 1024 * 2), o_ssq = take((size_t)T * 16 * 4);
    const size_t o_q = take((size_t)T * 1024 * 2), o_k = take((size_t)T * 1024 * 2), o_v = take((size_t)T * 1024 * 2), o_iq = take((size_t)T * 1024 * 2);
    const size_t o_ik = take((size_t)T * 64 * 2), o_iw = take((size_t)T * 16 * 4);
    const size_t o_xr = take((size_t)T * DR * 2), o_sgr = take((size_t)T * DR * 2);
    const size_t o_bm = take((size_t)NB * 64 * S * 8), o_agg = take((size_t)NB * 32 * DR * 2 * 4), o_bar = take((size_t)XCD_BAR_WORDS * 4), o_halo = take((size_t)16 * 3 * DR * 2);
    if (grid == 0) {
        if (n_in != 15 || out_size != T * 1024 || ws_size < off) { fprintf(stderr, "kernel_launch: unexpected shapes / workspace (n_in %d out %d ws %zu need %zu)\n", n_in, out_size, ws_size, off); grid = -1; return; }
        int dev = 0, cus = 0, per_cu = 0;
        (void)hipGetDevice(&dev); (void)hipDeviceGetAttribute(&cus, hipDeviceAttributeMultiprocessorCount, dev);
        if (hipFuncSetAttribute((const void*)hybrid_fwd, hipFuncAttributeMaxDynamicSharedMemorySize, LDS_BYTES) != hipSuccess) { fprintf(stderr, "kernel_launch: hipFuncSetAttribute failed\n"); grid = -1; return; }
        if (hipOccupancyMaxActiveBlocksPerMultiprocessor(&per_cu, (const void*)hybrid_fwd, 512, LDS_BYTES) != hipSuccess || per_cu < 1) { fprintf(stderr, "kernel_launch: occupancy query failed (%d)\n", per_cu); per_cu = 1; }
        (void)hipGetLastError();
        grid = cus * 1;
        if (grid <= 0) grid = 256;
    }
    if (grid < 0) return;
    Params p{};
    p.x = (const float*)d_in[0]; p.pos = (const int*)d_in[1]; p.norm_g = (const float*)d_in[2]; p.w_in = (const float*)d_in[3];
    p.conv_w = (const float*)d_in[4]; p.conv_b = (const float*)d_in[5]; p.w_rg = (const float*)d_in[6]; p.b_rg = (const float*)d_in[7];
    p.w_ig = (const float*)d_in[8]; p.b_ig = (const float*)d_in[9]; p.lam = (const float*)d_in[10]; p.w_oa = (const float*)d_in[11];
    p.w_or = (const float*)d_in[12]; p.w_o = (const float*)d_in[13]; p.fin_g = (const float*)d_in[14];
    p.out = (float*)d_out;
    unsigned char* ws = (unsigned char*)d_ws;
    p.WinT = (bf16_t*)(ws + o_WinT); p.Wsm0 = (bf16_t*)(ws + o_W0); p.Wsm1 = (bf16_t*)(ws + o_W1);
    p.xb = (bf16_t*)(ws + o_xb); p.ssq = (float*)(ws + o_ssq); p.q = (bf16_t*)(ws + o_q); p.k = (bf16_t*)(ws + o_k); p.v = (bf16_t*)(ws + o_v);
    p.iq = (bf16_t*)(ws + o_iq); p.ik = (bf16_t*)(ws + o_ik); p.iw = (float*)(ws + o_iw); p.xr = (bf16_t*)(ws + o_xr); p.sgr = (bf16_t*)(ws + o_sgr);
    p.bm = (u64*)(ws + o_bm); p.agg = (float*)(ws + o_agg); p.bar = (unsigned*)(ws + o_bar); p.halo = (bf16_t*)(ws + o_halo);
    (void)hipMemsetAsync(ws + o_bar, 0, (size_t)XCD_BAR_WORDS * 4, stream);
#if N_LAUNCH_MODE == 1
    int lo = 0, hi = NPH; void* args[] = {&p, &lo, &hi};
    hipError_t e = hipLaunchCooperativeKernel((const void*)hybrid_fwd, dim3(grid), dim3(512), args, LDS_BYTES, stream);
    if (e != hipSuccess) fprintf(stderr, "cooperative launch failed: %s (grid %d)\n", hipGetErrorString(e), grid);
#else
    for (int ph = 0; ph < NPH; ++ph) hipLaunchKernelGGL(hybrid_fwd, dim3(grid), dim3(512), LDS_BYTES, stream, p, ph, ph + 1);
#endif
}
```
